# Optimizing an MI355X kernel written in HIP

```python
import jax, jax.numpy as jnp
from jax import lax
import numpy as np


D_MODEL = 1024
BATCH = 8
SEQ = 2048
DEPTH = 2
DEC_BATCH = 128
DEC_SEQ = 1
PAST_LEN = 16384
PAGE_SIZE = 128

CHUNK = 128
A_WIDTH = D_MODEL
A_HEADS = 8
A_HEAD_DIM = A_WIDTH // A_HEADS
B_WIDTH = D_MODEL
B_GROUPS = 8
CONV_W = 3
FFN_HIDDEN = ((8 * D_MODEL // 3 + 255) // 256) * 256
EPS = 1e-6
IN_COLS = 2 * A_WIDTH + 3 * B_WIDTH + 2 * D_MODEL
SPLITS = (A_WIDTH, 2 * A_WIDTH, 2 * A_WIDTH + B_WIDTH, 2 * A_WIDTH + 2 * B_WIDTH,
          2 * A_WIDTH + 3 * B_WIDTH, 2 * A_WIDTH + 3 * B_WIDTH + D_MODEL)

kernel_name = "hybrid_sgu_shortconv_decoder_step"


def rms_norm(x, g):
    xf = x.astype(jnp.float32)
    y = xf * lax.rsqrt(jnp.mean(xf * xf, axis=-1, keepdims=True) + EPS)
    return (y * g.astype(jnp.float32)).astype(x.dtype)


def layer_norm(x, g, b):
    xf = x.astype(jnp.float32)
    mu = jnp.mean(xf, axis=-1, keepdims=True)
    xc = xf - mu
    y = xc * lax.rsqrt(jnp.mean(xc * xc, axis=-1, keepdims=True) + EPS)
    return (y * g.astype(jnp.float32) + b.astype(jnp.float32)).astype(x.dtype)


def chunk_spatial_mix(v, w_s, b_s):
    nb, t, _ = v.shape
    n = -(-t // CHUNK)
    pad = n * CHUNK - t
    vp = jnp.pad(v, ((0, 0), (0, pad), (0, 0))).reshape(nb, n, CHUNK, A_HEADS, A_HEAD_DIM)
    causal = jnp.tril(jnp.ones((CHUNK, CHUNK), dtype=bool))
    ws = jnp.where(causal[None], w_s, jnp.zeros((), w_s.dtype))
    mixed = jnp.einsum("hij,bnjhd->bnihd", ws, vp) + b_s.T[:, :, None]
    return mixed.reshape(nb, n * CHUNK, A_WIDTH)[:, :t]


def short_conv(xp, w):
    t = xp.shape[1] - (CONV_W - 1)
    out = xp[:, 0:t] * w[0]
    for k in range(1, CONV_W):
        out = out + xp[:, k:k + t] * w[k]
    return out


def hybrid_mixer(xn, conv_hist, w_in, sgu_ln_g, sgu_ln_b, w_s, b_s, conv_w, w_a_out, w_b_out, w_o):
    z = jnp.einsum("btd,dc->btc", xn, w_in)
    u, v, b_gate, c_gate, x_in, r_a, r_b = jnp.split(z, SPLITS, axis=-1)
    u = jax.nn.gelu(u)
    v = layer_norm(jax.nn.gelu(v), sgu_ln_g, sgu_ln_b)
    y_a = jnp.einsum("btc,cd->btd", u * chunk_spatial_mix(v, w_s, b_s), w_a_out)
    c_in = c_gate * x_in
    xp = jnp.concatenate([conv_hist.astype(c_in.dtype), c_in], axis=1)
    y_b = jnp.einsum("btc,cd->btd", b_gate * short_conv(xp, conv_w), w_b_out)
    h = jax.nn.sigmoid(r_a) * y_a + jax.nn.sigmoid(r_b) * y_b
    out = jnp.einsum("btd,de->bte", h, w_o)
    return out, xp[:, -(CONV_W - 1):], v


def swiglu(x, w_gate, w_up, w_down):
    g = jnp.einsum("btd,df->btf", x, w_gate)
    up = jnp.einsum("btd,df->btf", x, w_up)
    return jnp.einsum("btf,fd->btd", jax.nn.silu(g) * up, w_down)


def decoder_layer(x, conv_hist, mix_pre_g, mix_post_g, w_in, sgu_ln_g, sgu_ln_b, w_s, b_s, conv_w,
                  w_a_out, w_b_out, w_o, ffn_pre_g, ffn_post_g, w_gate, w_up, w_down):
    h, new_hist, v = hybrid_mixer(rms_norm(x, mix_pre_g), conv_hist, w_in, sgu_ln_g, sgu_ln_b,
                                  w_s, b_s, conv_w, w_a_out, w_b_out, w_o)
    x = x + rms_norm(h, mix_post_g)
    f = swiglu(rms_norm(x, ffn_pre_g), w_gate, w_up, w_down)
    x = x + rms_norm(f, ffn_post_g)
    return x, new_hist, v


def setup_inputs(seed: int = 0) -> dict:
    key = jax.random.key(seed)
    ks = jax.random.split(key, 24)
    f32 = jnp.float32
    nrm = lambda k, shape, s: (jax.random.normal(k, shape, f32) * s)
    gain = lambda k, shape: (1.0 + 0.05 * jax.random.normal(k, shape, f32))
    return {
        "x_prompt": nrm(ks[0], (BATCH, SEQ, D_MODEL), 1.0),
        "x_sample": nrm(ks[1], (DEC_BATCH, DEC_SEQ, D_MODEL), 1.0),
        "state_conv": nrm(ks[2], (DEPTH, DEC_BATCH, CONV_W - 1, B_WIDTH), 0.5),
        "mix_pre_g": gain(ks[3], (DEPTH, D_MODEL)),
        "mix_post_g": gain(ks[4], (DEPTH, D_MODEL)),
        "w_in": nrm(ks[5], (DEPTH, D_MODEL, IN_COLS), D_MODEL ** -0.5),
        "sgu_ln_g": gain(ks[6], (DEPTH, A_WIDTH)),
        "sgu_ln_b": nrm(ks[7], (DEPTH, A_WIDTH), 0.02),
        "w_s": nrm(ks[8], (DEPTH, A_HEADS, CHUNK, CHUNK), CHUNK ** -0.5),
        "b_s": 1.0 + nrm(ks[9], (DEPTH, A_HEADS, CHUNK), 0.1),
        "conv_w": nrm(ks[10], (DEPTH, CONV_W, B_WIDTH), CONV_W ** -0.5),
        "w_a_out": nrm(ks[11], (DEPTH, A_WIDTH, D_MODEL), A_WIDTH ** -0.5),
        "w_b_out": nrm(ks[12], (DEPTH, B_WIDTH, D_MODEL), B_WIDTH ** -0.5),
        "w_o": nrm(ks[13], (DEPTH, D_MODEL, D_MODEL), D_MODEL ** -0.5),
        "ffn_pre_g": gain(ks[14], (DEPTH, D_MODEL)),
        "ffn_post_g": gain(ks[15], (DEPTH, D_MODEL)),
        "w_gate": nrm(ks[16], (DEPTH, D_MODEL, FFN_HIDDEN), D_MODEL ** -0.5),
        "w_up": nrm(ks[17], (DEPTH, D_MODEL, FFN_HIDDEN), D_MODEL ** -0.5),
        "w_down": nrm(ks[18], (DEPTH, FFN_HIDDEN, D_MODEL), FFN_HIDDEN ** -0.5),
    }


def reference(x_prompt, x_sample, state_conv, mix_pre_g, mix_post_g, w_in, sgu_ln_g, sgu_ln_b, w_s,
              b_s, conv_w, w_a_out, w_b_out, w_o, ffn_pre_g, ffn_post_g, w_gate, w_up, w_down):
    xp_ = x_prompt
    xs_ = x_sample
    conv_prompt, conv_sample, chunk_v_sample = [], [], []
    for l in range(DEPTH):
        params = (mix_pre_g[l], mix_post_g[l], w_in[l], sgu_ln_g[l], sgu_ln_b[l], w_s[l], b_s[l],
                  conv_w[l], w_a_out[l], w_b_out[l], w_o[l], ffn_pre_g[l], ffn_post_g[l],
                  w_gate[l], w_up[l], w_down[l])
        hist0 = jnp.zeros((xp_.shape[0], CONV_W - 1, B_WIDTH), xp_.dtype)
        xp_, hp, _ = decoder_layer(xp_, hist0, *params)
        xs_, hs, vs = decoder_layer(xs_, state_conv[l], *params)
        conv_prompt.append(hp)
        conv_sample.append(hs)
        chunk_v_sample.append(vs)
    new_conv_prompt = jnp.stack(conv_prompt)
    new_conv_sample = jnp.stack(conv_sample)
    new_chunk_v_sample = jnp.stack(chunk_v_sample)
    return (xp_, xs_, new_conv_prompt, new_conv_sample, new_chunk_v_sample)
```

```cpp
#include <hip/hip_runtime.h>
#include <cstdio>
#include <cstdint>

#define LAS __attribute__((address_space(3)))
#define GAS __attribute__((address_space(1)))
typedef unsigned short bf16_t;
typedef short bf16x8 __attribute__((ext_vector_type(8)));
typedef float f32x4 __attribute__((ext_vector_type(4)));
typedef float f32x2 __attribute__((ext_vector_type(2)));
typedef unsigned u32x4 __attribute__((ext_vector_type(4)));
typedef unsigned u32x2 __attribute__((ext_vector_type(2)));

constexpr int D = 1024, NPROMPT = 16384, NSAMP = 128, SEQ = 2048, NB = 8;
constexpr int M = NPROMPT + NSAMP;
constexpr int MP = 16640;
constexpr int INC = 7168, FF = 2816, NGU = 2 * FF;
constexpr int NA1 = 5120, NA2 = 2048;
constexpr float EPS = 1e-6f;
constexpr int NWAVES = 8;

constexpr size_t O_Y = 0, O_CP = (size_t)M * D, O_CS = O_CP + 2 * NB * 2 * D, O_V = O_CS + 2 * NSAMP * 2 * D, O_END = O_V + 2 * NSAMP * D;

constexpr size_t MiB = 1u << 20;
constexpr size_t WS_CTL = 0, CTL_ZERO_BYTES = 1 * MiB;
constexpr size_t WS_STATS = 1 * MiB;
constexpr size_t WS_W = 4 * MiB;
constexpr size_t W_IN = 0, W_AB = 14 * MiB, W_O = 18 * MiB, W_GU = 20 * MiB, W_DN = 31 * MiB, W_LAYER = 36 * MiB + MiB / 2;
constexpr size_t SLOT = (size_t)MP * D * 2;
constexpr size_t WS_S0 = WS_W + 2 * W_LAYER, WS_END = WS_S0 + 5 * SLOT;
constexpr int CW_BAR = 4096;

__device__ __forceinline__ unsigned cvt_pk_bf16(float lo, float hi) { unsigned r; asm volatile("v_cvt_pk_bf16_f32 %0, %1, %2" : "=v"(r) : "v"(lo), "v"(hi)); return r; }
__device__ __forceinline__ float bf_lo(unsigned w) { return __uint_as_float(w << 16); }
__device__ __forceinline__ float bf_hi(unsigned w) { return __uint_as_float(w & 0xffff0000u); }
__device__ __forceinline__ float fast_exp(float x) { return __builtin_amdgcn_exp2f(x * 1.44269504089f); }
__device__ __forceinline__ float sigmoidf_(float x) { return __builtin_amdgcn_rcpf(1.0f + fast_exp(-x)); }
__device__ __forceinline__ float gelu_tanh(float x) { const float u = x * (1.5957691216f + 0.0713548163f * x * x); return x * __builtin_amdgcn_rcpf(1.0f + fast_exp(-u)); }
__device__ __forceinline__ float wave_sum(float v) {
#pragma unroll
    for (int o = 1; o < 64; o <<= 1) v += __shfl_xor(v, o);
    return v;
}
#define LDS_WAIT() asm volatile("s_waitcnt lgkmcnt(0)" ::: "memory")
#define VM_WAIT() asm volatile("s_waitcnt vmcnt(0)" ::: "memory")

namespace pg8 {
constexpr int BM = 256, BK = 64, HALF = 128, HTB = HALF * BK * 2, STAGE_BYTES = 8 * HTB, NXCD = 8, WGM = 8;
__host__ __device__ __forceinline__ int lds_byte(int r, int c) { const int st = (r >> 4) * 2 + (c >> 5), rr = r & 15, cc = c & 31, ob = rr * 64 + cc * 2; return st * 1024 + (ob ^ (((ob >> 9) & 1) << 5)); }
__host__ __device__ __forceinline__ void stage_rc(int b, int& R, int& C) { const int st = b / 1024, sb = b % 1024, swz = sb ^ (((sb >> 9) & 1) << 5); R = (st >> 1) * 16 + swz / 64; C = (st & 1) * 32 + (swz % 64) / 2; }
__host__ __device__ __forceinline__ int perm32(int rho) { const int n = rho >> 4, i = rho & 15; return 8 * (i >> 2) + 4 * n + (i & 3); }

struct Unit { int pm, pn, part; };
struct Gemm { const bf16_t* A; const bf16_t* Bt; int lda, ldb, K, part_off; };

struct StaticOrder {
    int nM, nN, nwg, G, c;
    __host__ __device__ void init(int Mrows, int N, int G_, int c_) { nM = Mrows / BM; nN = N / BM; nwg = nM * nN; G = G_; c = c_; }
    __host__ __device__ bool next(int i, Unit& u) const {
        const long L = (long)i * G + c; if (L >= nwg) return false;
        int wgid = (int)L; { const int q = nwg / NXCD, r = nwg % NXCD, xcd = wgid % NXCD, off = wgid / NXCD; wgid = (xcd < r ? xcd * (q + 1) : r * (q + 1) + (xcd - r) * q) + off; }
        const int nig = WGM * nN, gid = wgid / nig, fm = gid * WGM, gsz = (nM - fm) < WGM ? (nM - fm) : WGM;
        u.pm = fm + ((wgid % nig) % gsz); u.pn = (wgid % nig) / gsz; u.part = 0; return true;
    }
};
struct PairOrder {
    StaticOrder S;
    __host__ __device__ bool next(int i, Unit& u) const { if (!S.next(i >> 1, u)) return false; u.part = i & 1; return true; }
};

typedef f32x4 Acc[2][2][4][2];

template <class Epi, class Sched>
__device__ __forceinline__ void gemm_phase(LAS unsigned char* lds, const Gemm g, const Sched& S, const Epi& E) {
    int tid_ = threadIdx.x; asm volatile("" : "+v"(tid_));
    const int tid = tid_, wid = __builtin_amdgcn_readfirstlane(tid >> 6), lane = tid & 63, wr = wid >> 2, wc = wid & 3, fr = lane & 15, fq = lane >> 4;
    const int K = g.K, nt = K / BK;
    unsigned voffA[2], voffB[2];
#pragma unroll
    for (int i = 0; i < 2; ++i) { int R, C; stage_rc(tid * 16 + i * 8192, R, C); const int Rb = (R & ~31) + perm32(R & 31);
        voffA[i] = (unsigned)(R * g.lda + C) * 2u; voffB[i] = (unsigned)(Rb * g.ldb + C) * 2u; }
    const size_t kstep = (size_t)(BK * 2);
    const size_t hstepA = (size_t)HALF * g.lda * 2, hstepB = (size_t)HALF * g.ldb * 2;
    const size_t tstepA = 2 * hstepA, tstepB = 2 * hstepB, pstep = (size_t)g.part_off * 2;
    const unsigned ldsw = (unsigned)wid * 1024u;
    const int aoff = lds_byte(wr * 64 + fr, fq * 8), boff = lds_byte(wc * 32 + fr, fq * 8);
#define PG8_SA(b, h) (((b) * 2 + (h)) * HTB)
#define PG8_SB(b, h) ((4 + (b) * 2 + (h)) * HTB)
#define PG8_STAGE(bufoff, gbase, voff) do { _Pragma("unroll") for (int _i = 0; _i < 2; ++_i) \
        __builtin_amdgcn_global_load_lds((const unsigned*)((const char*)(gbase) + (voff)[_i]), (LAS unsigned*)(lds + (bufoff) + ldsw + _i * 8192), 16, 0, 0); } while (0)
#define PG8_LDA(dst, b, h) do { _Pragma("unroll") for (int m = 0; m < 4; ++m) _Pragma("unroll") for (int k = 0; k < 2; ++k) dst[m][k] = *(const LAS bf16x8*)(lds + PG8_SA(b, h) + aoff + m * 2048 + k * 1024); } while (0)
#define PG8_LDB(dst, b, h) do { _Pragma("unroll") for (int n = 0; n < 2; ++n) _Pragma("unroll") for (int k = 0; k < 2; ++k) dst[n][k] = *(const LAS bf16x8*)(lds + PG8_SB(b, h) + boff + n * 2048 + k * 1024); } while (0)
#define PG8_MMA(ai, bj, At, Bt) do { __builtin_amdgcn_s_setprio(1); _Pragma("unroll") for (int m = 0; m < 4; ++m) _Pragma("unroll") for (int n = 0; n < 2; ++n) _Pragma("unroll") for (int k = 0; k < 2; ++k) \
        acc[ai][bj][m][n] = __builtin_amdgcn_mfma_f32_16x16x32_bf16(Bt[n][k], At[m][k], acc[ai][bj][m][n], 0, 0, 0); __builtin_amdgcn_s_setprio(0); } while (0)
#define PG8_WAIT_V(n) asm volatile("s_waitcnt vmcnt(" #n ")" ::: "memory")
#define PG8_WAIT_L(n) asm volatile("s_waitcnt lgkmcnt(" #n ")" ::: "memory")
#define PG8_BAR __builtin_amdgcn_s_barrier()
#define PG8_SCHED __builtin_amdgcn_sched_barrier(0)
    Unit cur, nxt; int ui = 0;
    if (!S.next(0, cur)) return;
    Acc acc;
#pragma unroll
    for (int a = 0; a < 2; ++a)
#pragma unroll
        for (int b = 0; b < 2; ++b)
#pragma unroll
            for (int m = 0; m < 4; ++m)
#pragma unroll
                for (int n = 0; n < 2; ++n) acc[a][b][m][n] = (f32x4){0.f, 0.f, 0.f, 0.f};
    bf16x8 At[4][2], B0[2][2], B1[2][2];
    const char* cA = (const char*)g.A + (size_t)cur.pm * tstepA + (size_t)cur.part * pstep; const char* cB = (const char*)g.Bt + (size_t)cur.pn * tstepB + (size_t)cur.part * pstep;
    PG8_STAGE(PG8_SB(0, 0), cB, voffB); PG8_STAGE(PG8_SB(0, 1), cB + hstepB, voffB); PG8_STAGE(PG8_SA(0, 0), cA, voffA); PG8_STAGE(PG8_SA(0, 1), cA + hstepA, voffA);
    if (wr == 1) PG8_BAR;
    PG8_WAIT_V(2); PG8_BAR;
    PG8_STAGE(PG8_SB(1, 0), cB + kstep, voffB); PG8_STAGE(PG8_SA(1, 0), cA + kstep, voffA); PG8_STAGE(PG8_SB(1, 1), cB + hstepB + kstep, voffB);
    PG8_WAIT_V(6); PG8_BAR;
    for (;;) {
        const bool has_next = S.next(ui + 1, nxt);
        const char* nA = has_next ? (const char*)g.A + (size_t)nxt.pm * tstepA + (size_t)nxt.part * pstep : cA;
        const char* nB = has_next ? (const char*)g.Bt + (size_t)nxt.pn * tstepB + (size_t)nxt.part * pstep : cB;
        for (int t = 0; t < nt; t += 2) {
            const bool last = (t == nt - 2);
            const char* a1 = cA + (size_t)(t + 1) * kstep;
            const char* a2 = last ? nA : cA + (size_t)(t + 2) * kstep; const char* b2 = last ? nB : cB + (size_t)(t + 2) * kstep;
            const char* a3 = a2 + kstep; const char* b3 = b2 + kstep;
            PG8_LDB(B0, 0, 0); PG8_LDB(B1, 0, 1); PG8_SCHED; PG8_LDA(At, 0, 0); PG8_STAGE(PG8_SA(1, 1), a1 + hstepA, voffA);
            PG8_WAIT_V(8); PG8_WAIT_L(0); PG8_BAR; PG8_MMA(0, 0, At, B0); PG8_MMA(0, 1, At, B1); PG8_BAR; PG8_SCHED;
            PG8_LDA(At, 0, 1); PG8_STAGE(PG8_SB(0, 0), b2, voffB); PG8_STAGE(PG8_SB(0, 1), b2 + hstepB, voffB); PG8_STAGE(PG8_SA(0, 0), a2, voffA);
            PG8_WAIT_V(8); PG8_WAIT_L(0); PG8_BAR; PG8_MMA(1, 0, At, B0); PG8_MMA(1, 1, At, B1); PG8_BAR; PG8_SCHED;
            PG8_LDB(B0, 1, 0); PG8_LDB(B1, 1, 1); PG8_SCHED; PG8_LDA(At, 1, 0); PG8_STAGE(PG8_SA(0, 1), a2 + hstepA, voffA);
            PG8_WAIT_V(8); PG8_WAIT_L(0); PG8_BAR; PG8_MMA(0, 0, At, B0); PG8_MMA(0, 1, At, B1); PG8_BAR; PG8_SCHED;
            PG8_LDA(At, 1, 1); PG8_STAGE(PG8_SB(1, 0), b3, voffB); PG8_STAGE(PG8_SB(1, 1), b3 + hstepB, voffB); PG8_STAGE(PG8_SA(1, 0), a3, voffA);
            PG8_WAIT_V(8); PG8_WAIT_L(0); PG8_BAR; PG8_MMA(1, 0, At, B0); PG8_MMA(1, 1, At, B1); PG8_BAR; PG8_SCHED;
        }
        if (wr == 0) PG8_BAR;
        E(acc, cur, wr, wc, fr, fq);
        if (!has_next) break;
        if (nxt.part == 0) {
#pragma unroll
            for (int a = 0; a < 2; ++a)
#pragma unroll
                for (int b = 0; b < 2; ++b)
#pragma unroll
                    for (int m = 0; m < 4; ++m)
#pragma unroll
                        for (int n = 0; n < 2; ++n) acc[a][b][m][n] = (f32x4){0.f, 0.f, 0.f, 0.f};
        }
        cur = nxt; cA = nA; cB = nB; ++ui;
        if (wr == 1) PG8_BAR;
    }
    PG8_WAIT_V(0);
    PG8_BAR;
#undef PG8_SA
#undef PG8_SB
#undef PG8_STAGE
#undef PG8_LDA
#undef PG8_LDB
#undef PG8_MMA
#undef PG8_WAIT_V
#undef PG8_WAIT_L
#undef PG8_BAR
#undef PG8_SCHED
}

__device__ __forceinline__ u32x4 pack8(const f32x4 v0, const f32x4 v1) { u32x4 w; w.x = cvt_pk_bf16(v0[0], v0[1]); w.y = cvt_pk_bf16(v0[2], v0[3]); w.z = cvt_pk_bf16(v1[0], v1[1]); w.w = cvt_pk_bf16(v1[2], v1[3]); return w; }

struct EpiPlain {
    bf16_t* O; int ldc;
    __device__ __forceinline__ void operator()(Acc& acc, const Unit& u, int wr, int wc, int fr, int fq) const {
        const int row0 = u.pm * BM + wr * 64 + fr, col0 = u.pn * BM + wc * 32 + 8 * fq;
#pragma unroll
        for (int ai = 0; ai < 2; ++ai)
#pragma unroll
            for (int m = 0; m < 4; ++m) { bf16_t* rowp = O + (size_t)(row0 + ai * HALF + m * 16) * ldc + col0;
#pragma unroll
                for (int bj = 0; bj < 2; ++bj) *(u32x4*)(rowp + bj * HALF) = pack8(acc[ai][bj][m][0], acc[ai][bj][m][1]); }
    }
};

struct EpiA1 {
    bf16_t* UB; bf16_t* GV; bf16_t* CIN; float* STATS; float* out_cp; float* out_cs;
    __device__ __forceinline__ void operator()(Acc& acc, const Unit& u, int wr, int wc, int fr, int fq) const {
        const int row0 = u.pm * BM + wr * 64 + fr, t = u.pn, cl = wc * 32 + 8 * fq;
        if (t < 4 || (t >= 8 && t < 12)) {
            const bool isu = t < 4; const int col0 = (isu ? t * 256 : 1024 + (t - 8) * 256) + cl;
#pragma unroll
            for (int ai = 0; ai < 2; ++ai)
#pragma unroll
                for (int m = 0; m < 4; ++m) { bf16_t* rowp = UB + (size_t)(row0 + ai * HALF + m * 16) * 2048 + col0;
#pragma unroll
                    for (int bj = 0; bj < 2; ++bj) { f32x4 v0 = acc[ai][bj][m][0], v1 = acc[ai][bj][m][1];
                        if (isu) {
#pragma unroll
                            for (int e = 0; e < 4; ++e) { v0[e] = gelu_tanh(v0[e]); v1[e] = gelu_tanh(v1[e]); } }
                        *(u32x4*)(rowp + bj * HALF) = pack8(v0, v1); } }
        } else if (t < 8) {
            const int col0 = (t - 4) * 256 + cl;
#pragma unroll
            for (int ai = 0; ai < 2; ++ai)
#pragma unroll
                for (int m = 0; m < 4; ++m) { const int row = row0 + ai * HALF + m * 16; bf16_t* rowp = GV + (size_t)row * D + col0; float s = 0.f, q = 0.f;
#pragma unroll
                    for (int bj = 0; bj < 2; ++bj) { f32x4 v0 = acc[ai][bj][m][0], v1 = acc[ai][bj][m][1];
#pragma unroll
                        for (int e = 0; e < 4; ++e) { v0[e] = gelu_tanh(v0[e]); v1[e] = gelu_tanh(v1[e]); s += v0[e] + v1[e]; q += v0[e] * v0[e] + v1[e] * v1[e]; }
                        *(u32x4*)(rowp + bj * HALF) = pack8(v0, v1); }
                    s += __shfl_xor(s, 16); s += __shfl_xor(s, 32); q += __shfl_xor(q, 16); q += __shfl_xor(q, 32);
                    if (fq == 0) *(f32x2*)(STATS + (size_t)row * 32 + ((t - 4) * 4 + wc) * 2) = (f32x2){s, q}; }
        } else {
            const int col0 = (t - 12) * 128 + cl;
#pragma unroll
            for (int ai = 0; ai < 2; ++ai)
#pragma unroll
                for (int m = 0; m < 4; ++m) { const int row = row0 + ai * HALF + m * 16;
                    const f32x4 p0 = acc[ai][0][m][0] * acc[ai][1][m][0], p1 = acc[ai][0][m][1] * acc[ai][1][m][1];
                    *(u32x4*)(CIN + (size_t)row * D + col0) = pack8(p0, p1);
                    if (row < NPROMPT) { const int tp = row & (SEQ - 1);
                        if (tp >= SEQ - 2) { float* o = out_cp + ((size_t)(row >> 11) * 2 + (tp - (SEQ - 2))) * D + col0; *(f32x4*)o = p0; *(f32x4*)(o + 4) = p1; } }
                    else if (row < M) { float* o = out_cs + ((size_t)(row - NPROMPT) * 2 + 1) * D + col0; *(f32x4*)o = p0; *(f32x4*)(o + 4) = p1; } }
        }
    }
};
struct EpiA2 {
    bf16_t* RATIO; bf16_t* SB;
    __device__ __forceinline__ void operator()(Acc& acc, const Unit& u, int wr, int wc, int fr, int fq) const {
        const int row0 = u.pm * BM + wr * 64 + fr, col0 = u.pn * 128 + wc * 32 + 8 * fq;
#pragma unroll
        for (int ai = 0; ai < 2; ++ai)
#pragma unroll
            for (int m = 0; m < 4; ++m) { const size_t off = (size_t)(row0 + ai * HALF + m * 16) * D + col0; f32x4 rt[2], sb[2];
#pragma unroll
                for (int n = 0; n < 2; ++n)
#pragma unroll
                    for (int e = 0; e < 4; ++e) { const float ea = 1.0f + fast_exp(-acc[ai][0][m][n][e]), eb = 1.0f + fast_exp(-acc[ai][1][m][n][e]); const float ra = __builtin_amdgcn_rcpf(ea);
                        sb[n][e] = __builtin_amdgcn_rcpf(eb); rt[n][e] = eb * ra; }
                *(u32x4*)(RATIO + off) = pack8(rt[0], rt[1]); *(u32x4*)(SB + off) = pack8(sb[0], sb[1]); }
    }
};
struct EpiB {
    const bf16_t* RATIO; const bf16_t* SB; bf16_t* H;
    __device__ __forceinline__ void operator()(Acc& acc, const Unit& u, int wr, int wc, int fr, int fq) const {
        const int row0 = u.pm * BM + wr * 64 + fr, col0 = u.pn * BM + wc * 32 + 8 * fq;
        const bf16_t* S = u.part == 0 ? RATIO : SB;
#pragma unroll
        for (int ai = 0; ai < 2; ++ai)
#pragma unroll
            for (int m = 0; m < 4; ++m) { const size_t off = (size_t)(row0 + ai * HALF + m * 16) * D + col0;
#pragma unroll
                for (int bj = 0; bj < 2; ++bj) { const u32x4 w = *(const u32x4*)(S + off + bj * HALF);
                    f32x4 s0 = {bf_lo(w.x), bf_hi(w.x), bf_lo(w.y), bf_hi(w.y)}, s1 = {bf_lo(w.z), bf_hi(w.z), bf_lo(w.w), bf_hi(w.w)};
                    acc[ai][bj][m][0] *= s0; acc[ai][bj][m][1] *= s1;
                    if (u.part == 1) *(u32x4*)(H + off + bj * HALF) = pack8(acc[ai][bj][m][0], acc[ai][bj][m][1]); } }
    }
};
struct EpiD {
    bf16_t* Aout;
    __device__ __forceinline__ void operator()(Acc& acc, const Unit& u, int wr, int wc, int fr, int fq) const {
        const int row0 = u.pm * BM + wr * 64 + fr, col0 = u.pn * 128 + wc * 32 + 8 * fq;
#pragma unroll
        for (int ai = 0; ai < 2; ++ai)
#pragma unroll
            for (int m = 0; m < 4; ++m) { f32x4 o[2];
#pragma unroll
                for (int n = 0; n < 2; ++n)
#pragma unroll
                    for (int e = 0; e < 4; ++e) { const float gte = acc[ai][0][m][n][e]; o[n][e] = gte * sigmoidf_(gte) * acc[ai][1][m][n][e]; }
                *(u32x4*)(Aout + (size_t)(row0 + ai * HALF + m * 16) * FF + col0) = pack8(o[0], o[1]); }
    }
};
}

#define XB_TMO      128
#define XB_XCNT(j)  (256  + 64 * (j))
#define XB_XSUB(j)  (1280 + 64 * (j))
#define XB_XGEN(j)  (2304 + 64 * (j))
#define XB_TOP      3328
#define XB_TOPGEN   3392
#define XCD_BAR_WORDS 3456
#define XB_SPIN_CAP (1u << 18)
__device__ __forceinline__ unsigned xb_ld(unsigned* p)              { return __hip_atomic_load(p, __ATOMIC_RELAXED, __HIP_MEMORY_SCOPE_AGENT); }
__device__ __forceinline__ unsigned xb_add(unsigned* p, unsigned v) { return __hip_atomic_fetch_add(p, v, __ATOMIC_RELAXED, __HIP_MEMORY_SCOPE_AGENT); }
__device__ __forceinline__ unsigned xb_xcc_id() { return (unsigned)__builtin_amdgcn_s_getreg((3 << 11) | 20) & 0xFu; }
#define XB_SPIN(cond, bar) do { unsigned _sp = 0; while (cond) { __builtin_amdgcn_s_sleep(1); \
    if ((++_sp & 255u) == 0u) { if (xb_ld(&(bar)[XB_TMO])) break; if (_sp > XB_SPIN_CAP) { atomicAdd(&(bar)[XB_TMO], 1u); break; } } } } while (0)
struct XcdBarrier { unsigned* bar; unsigned x; volatile LAS unsigned* st; };
__device__ __forceinline__ XcdBarrier xcd_barrier_post(unsigned* bar, volatile LAS unsigned* st) {
    XcdBarrier b; b.bar = bar; b.x = xb_xcc_id(); b.st = st;
    if (threadIdx.x == 0) (void)xb_add(&bar[XB_XCNT(b.x)], 1u);
    return b;
}
__device__ __forceinline__ void xcd_barrier_complete(unsigned* bar, unsigned x, unsigned& nloc, unsigned& nx) {
    const unsigned G = gridDim.x * gridDim.y * gridDim.z;
    unsigned sum, cnt, mine, sp = 0u;
    for (;;) {
        sum = 0u; cnt = 0u; mine = 0u;
#pragma unroll
        for (unsigned j = 0; j < 16; ++j) { const unsigned c = xb_ld(&bar[XB_XCNT(j)]); sum += c; cnt += (c > 0u) ? 1u : 0u; mine = (j == x) ? c : mine; }
        if (sum == G) break;
        __builtin_amdgcn_s_sleep(1);
        if ((++sp & 255u) == 0u) { if (xb_ld(&bar[XB_TMO])) break; if (sp > XB_SPIN_CAP) { atomicAdd(&bar[XB_TMO], 1u); break; } }
    }
    nloc = mine > 0u ? mine : 1u; nx = cnt > 0u ? cnt : 1u;
}
__device__ __forceinline__ void xcd_barrier(const XcdBarrier& b) {
    asm volatile("s_waitcnt vmcnt(0)" ::: "memory");
    __syncthreads();
    if (threadIdx.x == 0) {
        unsigned* bar = b.bar;
        __builtin_amdgcn_s_waitcnt(0);
        unsigned nloc = b.st[0], nx = b.st[1];
        if (nloc == 0u) { xcd_barrier_complete(bar, b.x, nloc, nx); b.st[0] = nloc; b.st[1] = nx; }
        const unsigned old = xb_add(&bar[XB_XSUB(b.x)], 1u);
        const unsigned gen = old / nloc;
        if (old + 1u == (gen + 1u) * nloc) {
            __builtin_amdgcn_fence(__ATOMIC_RELEASE, "agent");
            asm volatile("s_waitcnt vmcnt(0)" ::: "memory");
            const unsigned og = xb_add(&bar[XB_TOP], 1u);
            const unsigned tg = og / nx;
            if (og + 1u == (tg + 1u) * nx) xb_add(&bar[XB_TOPGEN], 1u);
            else XB_SPIN(xb_ld(&bar[XB_TOPGEN]) == tg, bar);
            __builtin_amdgcn_fence(__ATOMIC_ACQUIRE, "agent");
            xb_add(&bar[XB_XGEN(b.x)], 1u);
            asm volatile("s_waitcnt vmcnt(0)" ::: "memory");
        } else {
            XB_SPIN(xb_ld(&bar[XB_XGEN(b.x)]) == gen, bar);
            __builtin_amdgcn_fence(__ATOMIC_ACQUIRE, "agent");
            asm volatile("s_waitcnt vmcnt(0)" ::: "memory");
        }
    }
    __syncthreads();
}

constexpr int RING_BYTES = 131072, LDSCTL_OFF = RING_BYTES, MISC_OFF = LDSCTL_OFF + 320, LDS_BYTES = 147456;
struct Args { const float* in[19]; float* out; unsigned char* ws; };
struct Frame { LAS unsigned char* lds; int tid, lane, wave, G, bid; };
#define CAS __attribute__((address_space(4)))
typedef const CAS unsigned char* kptr_t;
__device__ __forceinline__ kptr_t kargs() { kptr_t p = (kptr_t)__builtin_amdgcn_kernarg_segment_ptr(); asm volatile("" : "+s"(p)); return p; }
__device__ __forceinline__ const float* inp(int i) { return *(const float* const CAS*)(kargs() + 8 * i); }
__device__ __forceinline__ float* outp() { return *(float* const CAS*)(kargs() + 8 * 19); }
__device__ __forceinline__ unsigned char* wsp() { return *(unsigned char* const CAS*)(kargs() + 8 * 20); }

__device__ __forceinline__ void transpose_item(const float* W, int N, int k0, int scol0, bf16_t* WT, int drow0, int ldk, int koff, LAS float* scr, int lane) {
#pragma unroll 8
    for (int i = 0; i < 32; ++i) { const int kk = 2 * i + (lane >> 5); scr[kk * 33 + (lane & 31)] = W[(size_t)(k0 + kk) * N + scol0 + (lane & 31)]; }
    LDS_WAIT(); asm volatile("" ::: "memory");
    const int c = lane & 7;
#pragma unroll
    for (int j = 0; j < 4; ++j) { const int n = (lane >> 3) + 8 * j; const LAS float* s = scr + (8 * c) * 33 + n;
        u32x4 o; o.x = cvt_pk_bf16(s[0 * 33], s[1 * 33]); o.y = cvt_pk_bf16(s[2 * 33], s[3 * 33]); o.z = cvt_pk_bf16(s[4 * 33], s[5 * 33]); o.w = cvt_pk_bf16(s[6 * 33], s[7 * 33]);
        *(u32x4*)(WT + (size_t)(drow0 + n) * ldk + koff + k0 + 8 * c) = o; }
    LDS_WAIT(); asm volatile("" ::: "memory");
}
__device__ __forceinline__ int win_src(int p) {
    const int t = p >> 8, r = p & 255;
    if (t < 12) return p;
    if (t < 20) { const int j = t - 12; return r < 128 ? 3072 + 128 * j + r : 4096 + 128 * j + (r - 128); }
    const int j = t - 20; return r < 128 ? 5120 + 128 * j + r : 6144 + 128 * j + (r - 128);
}
__device__ __forceinline__ void p0_weights(Frame& F) {
    LAS float* scr = (LAS float*)(F.lds + F.wave * 16384);
    const int gw = F.bid * NWAVES + F.wave, NGW = F.G * NWAVES;
    constexpr int I_IN = 16 * (INC / 32), I_SQ = 16 * (D / 32), I_GU = 16 * (NGU / 32), I_DN = (FF / 64) * (D / 32);
    constexpr int PER_LAYER = I_IN + 3 * I_SQ + I_GU + I_DN;
    for (int it = gw; it < 2 * PER_LAYER; it += NGW) {
        const int l = it / PER_LAYER; int r = it % PER_LAYER;
        unsigned char* wl = wsp() + WS_W + (size_t)l * W_LAYER;
        if (r < I_IN) { const int nb = r % (INC / 32), kb = r / (INC / 32); transpose_item(inp(5) + (size_t)l * D * INC, INC, 64 * kb, win_src(32 * nb), (bf16_t*)(wl + W_IN), 32 * nb, D, 0, scr, F.lane); continue; } r -= I_IN;
        if (r < I_SQ) { const int nb = r % 32, kb = r / 32; transpose_item(inp(11) + (size_t)l * D * D, D, 64 * kb, 32 * nb, (bf16_t*)(wl + W_AB), 32 * nb, 2048, 0, scr, F.lane); continue; } r -= I_SQ;
        if (r < I_SQ) { const int nb = r % 32, kb = r / 32; transpose_item(inp(12) + (size_t)l * D * D, D, 64 * kb, 32 * nb, (bf16_t*)(wl + W_AB), 32 * nb, 2048, 1024, scr, F.lane); continue; } r -= I_SQ;
        if (r < I_SQ) { const int nb = r % 32, kb = r / 32; transpose_item(inp(13) + (size_t)l * D * D, D, 64 * kb, 32 * nb, (bf16_t*)(wl + W_O), 32 * nb, D, 0, scr, F.lane); continue; } r -= I_SQ;
        if (r < I_GU) { const int nb = r % (NGU / 32), kb = r / (NGU / 32); const int p = 32 * nb, j = p >> 8, rr = p & 255;
            const float* W = (rr < 128 ? inp(16) : inp(17)) + (size_t)l * D * FF; const int sc = 128 * j + (rr & 127);
            transpose_item(W, FF, 64 * kb, sc, (bf16_t*)(wl + W_GU), p, D, 0, scr, F.lane); continue; } r -= I_GU;
        { const int nb = r % 32, kb = r / 32; transpose_item(inp(18) + (size_t)l * FF * D, D, 64 * kb, 32 * nb, (bf16_t*)(wl + W_DN), 32 * nb, FF, 0, scr, F.lane); }
    }
}

__device__ __forceinline__ void norm_phase(Frame& F, const bf16_t* src, const float* g_res, const float* xin_prompt, const float* xin_sample, float* xout, const float* g_next, bf16_t* xn) {
    int tid_ = threadIdx.x; asm volatile("" : "+v"(tid_));
    const int lane = tid_ & 63, wave = __builtin_amdgcn_readfirstlane(tid_ >> 6);
    const int gw = F.bid * NWAVES + wave, NGW = F.G * NWAVES;
    f32x4 gr[4], gn[4];
#pragma unroll
    for (int j = 0; j < 4; ++j) { gr[j] = g_res ? *(const f32x4*)(g_res + 4 * lane + 256 * j) : (f32x4){0.f, 0.f, 0.f, 0.f}; gn[j] = g_next ? *(const f32x4*)(g_next + 4 * lane + 256 * j) : (f32x4){0.f, 0.f, 0.f, 0.f}; }
    for (int row = gw; row < MP; row += NGW) {
        if (row >= M) { if (xn) {
#pragma unroll
                for (int j = 0; j < 4; ++j) *(u32x2*)(xn + (size_t)row * D + 4 * lane + 256 * j) = (u32x2){0u, 0u}; }
            continue; }
        const float* xr = row < NPROMPT ? xin_prompt + (size_t)row * D : xin_sample + (size_t)(row - NPROMPT) * D;
        f32x4 x[4];
#pragma unroll
        for (int j = 0; j < 4; ++j) x[j] = *(const f32x4*)(xr + 4 * lane + 256 * j);
        if (src) {
            f32x4 o[4]; float ss = 0.f;
#pragma unroll
            for (int j = 0; j < 4; ++j) { const u32x2 w = *(const u32x2*)(src + (size_t)row * D + 4 * lane + 256 * j); o[j] = (f32x4){bf_lo(w.x), bf_hi(w.x), bf_lo(w.y), bf_hi(w.y)};
                ss += (o[j][0] * o[j][0] + o[j][1] * o[j][1]) + (o[j][2] * o[j][2] + o[j][3] * o[j][3]); }
            const float rs = 1.0f / sqrtf(wave_sum(ss) * (1.0f / D) + EPS);
#pragma unroll
            for (int j = 0; j < 4; ++j) x[j] = x[j] + o[j] * rs * gr[j];
        }
        if (xout) {
#pragma unroll
            for (int j = 0; j < 4; ++j) *(f32x4*)(xout + (size_t)row * D + 4 * lane + 256 * j) = x[j]; }
        if (xn) {
            float ss = 0.f;
#pragma unroll
            for (int j = 0; j < 4; ++j) ss += (x[j][0] * x[j][0] + x[j][1] * x[j][1]) + (x[j][2] * x[j][2] + x[j][3] * x[j][3]);
            const float rs = 1.0f / sqrtf(wave_sum(ss) * (1.0f / D) + EPS);
#pragma unroll
            for (int j = 0; j < 4; ++j) { const f32x4 y = x[j] * rs * gn[j]; *(u32x2*)(xn + (size_t)row * D + 4 * lane + 256 * j) = (u32x2){cvt_pk_bf16(y[0], y[1]), cvt_pk_bf16(y[2], y[3])}; }
        }
    }
}

constexpr int MP_PITCH = 136;
constexpr int MX_WS = 0, MX_VT = 128 * MP_PITCH * 2, MX_ST = 2 * 128 * MP_PITCH * 2;
__device__ __forceinline__ void mix_phase(Frame& F, int l) {
    int tid_ = threadIdx.x; asm volatile("" : "+v"(tid_));
    const int tid = tid_, lane = tid & 63, wave = __builtin_amdgcn_readfirstlane(tid >> 6), h = F.bid & 7;
    bf16_t* UB = (bf16_t*)(wsp() + WS_S0); const bf16_t* GV = (const bf16_t*)(wsp() + WS_S0 + 2 * SLOT); const bf16_t* CIN = (const bf16_t*)(wsp() + WS_S0 + 3 * SLOT);
    const float* STATS = (const float*)(wsp() + WS_STATS);
    LAS bf16_t* WSl = (LAS bf16_t*)(F.lds + MX_WS); LAS bf16_t* VT = (LAS bf16_t*)(F.lds + MX_VT); LAS f32x2* ST = (LAS f32x2*)(F.lds + MX_ST);
    const float* Ws = inp(8) + ((size_t)l * 8 + h) * 128 * 128;
    for (int idx = tid; idx < 128 * 32; idx += NWAVES * 64) { const int i = idx >> 5, j4 = (idx & 31) * 4; const f32x4 w = *(const f32x4*)(Ws + i * 128 + j4);
        const float a = j4 + 0 <= i ? w[0] : 0.f, b = j4 + 1 <= i ? w[1] : 0.f, c = j4 + 2 <= i ? w[2] : 0.f, d = j4 + 3 <= i ? w[3] : 0.f;
        *(LAS u32x2*)(WSl + i * MP_PITCH + j4) = (u32x2){cvt_pk_bf16(a, b), cvt_pk_bf16(c, d)}; }
    const int d8 = tid & 15, cb = 128 * h + 8 * d8;
    float lg[8], lb[8], cw0[8], cw1[8], cw2[8];
#pragma unroll
    for (int e = 0; e < 8; ++e) { lg[e] = inp(6)[l * D + cb + e]; lb[e] = inp(7)[l * D + cb + e]; cw0[e] = inp(10)[(l * 3 + 0) * D + cb + e]; cw1[e] = inp(10)[(l * 3 + 1) * D + cb + e]; cw2[e] = inp(10)[(l * 3 + 2) * D + cb + e]; }
    const float ws00 = Ws[0], bs0 = inp(9)[((size_t)l * 8 + h) * 128];
    const int nchunk = NPROMPT / 128;
    for (int c = F.bid >> 3; c <= nchunk; c += F.G >> 3) {
        const bool samp = c == nchunk; if (samp && (F.bid >> 3) != 0) break;
        const int r0 = c * 128;
#pragma unroll
        for (int q = 0; q < 4; ++q) { const int j = (tid >> 4) + 32 * q, row = r0 + j;
            u32x4 o = {0u, 0u, 0u, 0u};
            if (row < M) {
                const u32x4 c2 = *(const u32x4*)(CIN + (size_t)row * D + cb); const u32x4 bg = *(const u32x4*)(UB + (size_t)row * 2048 + 1024 + cb);
                float x1[8], x0[8];
                if (!samp) { const int tp = row & (SEQ - 1); u32x4 c1 = {0u, 0u, 0u, 0u}, c0 = {0u, 0u, 0u, 0u};
                    if (tp >= 1) c1 = *(const u32x4*)(CIN + (size_t)(row - 1) * D + cb);
                    if (tp >= 2) c0 = *(const u32x4*)(CIN + (size_t)(row - 2) * D + cb);
                    x1[0] = bf_lo(c1.x); x1[1] = bf_hi(c1.x); x1[2] = bf_lo(c1.y); x1[3] = bf_hi(c1.y); x1[4] = bf_lo(c1.z); x1[5] = bf_hi(c1.z); x1[6] = bf_lo(c1.w); x1[7] = bf_hi(c1.w);
                    x0[0] = bf_lo(c0.x); x0[1] = bf_hi(c0.x); x0[2] = bf_lo(c0.y); x0[3] = bf_hi(c0.y); x0[4] = bf_lo(c0.z); x0[5] = bf_hi(c0.z); x0[6] = bf_lo(c0.w); x0[7] = bf_hi(c0.w);
                } else { const float* hs = inp(2) + (((size_t)l * NSAMP + (row - NPROMPT)) * 2) * D + cb; float* oc = outp() + O_CS + (((size_t)l * NSAMP + (row - NPROMPT)) * 2) * D + cb;
#pragma unroll
                    for (int e = 0; e < 8; ++e) { x0[e] = hs[e]; x1[e] = hs[D + e]; oc[e] = x1[e]; } }
                const float x2[8] = {bf_lo(c2.x), bf_hi(c2.x), bf_lo(c2.y), bf_hi(c2.y), bf_lo(c2.z), bf_hi(c2.z), bf_lo(c2.w), bf_hi(c2.w)};
                const float bgf[8] = {bf_lo(bg.x), bf_hi(bg.x), bf_lo(bg.y), bf_hi(bg.y), bf_lo(bg.z), bf_hi(bg.z), bf_lo(bg.w), bf_hi(bg.w)};
                float r[8];
#pragma unroll
                for (int e = 0; e < 8; ++e) r[e] = bgf[e] * (cw0[e] * x0[e] + cw1[e] * x1[e] + cw2[e] * x2[e]);
                o.x = cvt_pk_bf16(r[0], r[1]); o.y = cvt_pk_bf16(r[2], r[3]); o.z = cvt_pk_bf16(r[4], r[5]); o.w = cvt_pk_bf16(r[6], r[7]);
            }
            *(u32x4*)(UB + (size_t)row * 2048 + 1024 + cb) = o; }
        if (tid < 128) { const float* sp = STATS + (size_t)(r0 + tid) * 32; float s = 0.f, q = 0.f;
#pragma unroll
            for (int k = 0; k < 8; ++k) { const f32x4 p = *(const f32x4*)(sp + 4 * k); s += p[0] + p[2]; q += p[1] + p[3]; }
            const float mean = s * (1.0f / D), var = q * (1.0f / D) - mean * mean; ST[tid] = (f32x2){mean, 1.0f / sqrtf(var + EPS)}; }
        LDS_WAIT(); __syncthreads();
        if (!samp) {
#pragma unroll
            for (int q = 0; q < 4; ++q) { const int j = (tid >> 4) + 32 * q; const u32x4 g = *(const u32x4*)(GV + (size_t)(r0 + j) * D + cb); const f32x2 st = ST[j];
                const float xv[8] = {bf_lo(g.x), bf_hi(g.x), bf_lo(g.y), bf_hi(g.y), bf_lo(g.z), bf_hi(g.z), bf_lo(g.w), bf_hi(g.w)};
#pragma unroll
                for (int e = 0; e < 8; e += 2) { const float y0 = (xv[e] - st.x) * st.y * lg[e] + lb[e], y1 = (xv[e + 1] - st.x) * st.y * lg[e + 1] + lb[e + 1]; const unsigned w = cvt_pk_bf16(y0, y1);
                    VT[(8 * d8 + e) * MP_PITCH + j] = (bf16_t)(w & 0xffffu); VT[(8 * d8 + e + 1) * MP_PITCH + j] = (bf16_t)(w >> 16); } }
            LDS_WAIT(); __syncthreads();
            const int i0 = 16 * wave, fr = lane & 15, fq = lane >> 4; f32x4 acc[8];
#pragma unroll
            for (int db = 0; db < 8; ++db) acc[db] = (f32x4){0.f, 0.f, 0.f, 0.f};
            for (int k0 = 0; k0 <= i0 + 15; k0 += 32) { const bf16x8 wf = *(const LAS bf16x8*)(WSl + (i0 + fr) * MP_PITCH + k0 + 8 * fq);
#pragma unroll
                for (int db = 0; db < 8; ++db) { const bf16x8 vf = *(const LAS bf16x8*)(VT + (16 * db + fr) * MP_PITCH + k0 + 8 * fq); acc[db] = __builtin_amdgcn_mfma_f32_16x16x32_bf16(vf, wf, acc[db], 0, 0, 0); } }
            const float bsv = inp(9)[((size_t)l * 8 + h) * 128 + i0 + fr];
#pragma unroll
            for (int db = 0; db < 8; ++db) { bf16_t* up = UB + (size_t)(r0 + i0 + fr) * 2048 + 128 * h + 16 * db + 4 * fq; const u32x2 uw = *(const u32x2*)up;
                const float a0 = bf_lo(uw.x) * (acc[db][0] + bsv), a1 = bf_hi(uw.x) * (acc[db][1] + bsv), a2 = bf_lo(uw.y) * (acc[db][2] + bsv), a3 = bf_hi(uw.y) * (acc[db][3] + bsv);
                *(u32x2*)up = (u32x2){cvt_pk_bf16(a0, a1), cvt_pk_bf16(a2, a3)}; }
        } else {
#pragma unroll
            for (int q = 0; q < 4; ++q) { const int j = (tid >> 4) + 32 * q, row = r0 + j; u32x4 o = {0u, 0u, 0u, 0u};
                if (row < M) { const u32x4 g = *(const u32x4*)(GV + (size_t)row * D + cb); const u32x4 uw = *(const u32x4*)(UB + (size_t)row * 2048 + cb); const f32x2 st = ST[j];
                    const float xv[8] = {bf_lo(g.x), bf_hi(g.x), bf_lo(g.y), bf_hi(g.y), bf_lo(g.z), bf_hi(g.z), bf_lo(g.w), bf_hi(g.w)};
                    const float uf[8] = {bf_lo(uw.x), bf_hi(uw.x), bf_lo(uw.y), bf_hi(uw.y), bf_lo(uw.z), bf_hi(uw.z), bf_lo(uw.w), bf_hi(uw.w)};
                    float* ov = outp() + O_V + ((size_t)l * NSAMP + (row - NPROMPT)) * D + cb; float r[8];
#pragma unroll
                    for (int e = 0; e < 8; ++e) { const float y = (xv[e] - st.x) * st.y * lg[e] + lb[e]; ov[e] = y; r[e] = uf[e] * (ws00 * y + bs0); }
                    o.x = cvt_pk_bf16(r[0], r[1]); o.y = cvt_pk_bf16(r[2], r[3]); o.z = cvt_pk_bf16(r[4], r[5]); o.w = cvt_pk_bf16(r[6], r[7]); }
                *(u32x4*)(UB + (size_t)row * 2048 + cb) = o; }
        }
        __syncthreads();
    }
}

#define SLOTP(i) ((bf16_t*)(wsp() + WS_S0 + (size_t)(i) * SLOT))
#define WLP(l, off) ((const bf16_t*)(wsp() + WS_W + (size_t)(l) * W_LAYER + (off)))
__global__ void __launch_bounds__(NWAVES * 64, 2) fwd_kernel(Args args) {
    extern __shared__ __attribute__((aligned(16))) unsigned char lds_raw[];
    Frame F;
    F.lds = (LAS unsigned char*)lds_raw;
    F.tid = threadIdx.x; F.lane = F.tid & 63; F.wave = __builtin_amdgcn_readfirstlane(F.tid >> 6);
    F.G = gridDim.x; F.bid = blockIdx.x;
    volatile LAS unsigned* MISC = (volatile LAS unsigned*)(F.lds + MISC_OFF);
    for (int u = F.tid; u < (LDS_BYTES - LDSCTL_OFF) / 4; u += NWAVES * 64) ((LAS unsigned*)(F.lds + LDSCTL_OFF))[u] = 0u;
    __syncthreads();
    XcdBarrier bar = xcd_barrier_post((unsigned*)(wsp() + WS_CTL) + CW_BAR, MISC + 8);
#define GRID_BAR() xcd_barrier(bar)

    p0_weights(F);
    norm_phase(F, nullptr, nullptr, inp(0), inp(1), nullptr, inp(3), SLOTP(4));
    GRID_BAR();

    for (int l = 0; l < 2; ++l) {
        {
            pg8::Gemm g{SLOTP(4), WLP(l, W_IN), D, D, D, 0}; pg8::StaticOrder S; S.init(MP, NA1, F.G, F.bid);
            pg8::EpiA1 E{SLOTP(0), SLOTP(2), SLOTP(3), (float*)(wsp() + WS_STATS), outp() + O_CP + (size_t)l * NB * 2 * D, outp() + O_CS + (size_t)l * NSAMP * 2 * D};
            pg8::gemm_phase(F.lds, g, S, E);
        }
        GRID_BAR();
        mix_phase(F, l);
        GRID_BAR();
        {
            pg8::Gemm g{SLOTP(4), WLP(l, W_IN) + (size_t)NA1 * D, D, D, D, 0}; pg8::StaticOrder S; S.init(MP, NA2, F.G, F.bid);
            pg8::EpiA2 E{SLOTP(2), SLOTP(3)};
            pg8::gemm_phase(F.lds, g, S, E);
        }
        GRID_BAR();
        {
            pg8::Gemm g{SLOTP(0), WLP(l, W_AB), 2048, 2048, D, D}; pg8::PairOrder S; S.S.init(MP, D, F.G, F.bid);
            pg8::EpiB E{SLOTP(2), SLOTP(3), SLOTP(4)};
            pg8::gemm_phase(F.lds, g, S, E);
        }
        GRID_BAR();
        {
            pg8::Gemm g{SLOTP(4), WLP(l, W_O), D, D, D, 0}; pg8::StaticOrder S; S.init(MP, D, F.G, F.bid);
            pg8::EpiPlain E{SLOTP(2), D};
            pg8::gemm_phase(F.lds, g, S, E);
        }
        GRID_BAR();
        {   float* Y = outp() + O_Y;
            norm_phase(F, SLOTP(2), inp(4) + l * D, l == 0 ? inp(0) : Y, l == 0 ? inp(1) : Y + (size_t)NPROMPT * D, Y, inp(14) + l * D, SLOTP(0)); }
        GRID_BAR();
        {
            pg8::Gemm g{SLOTP(0), WLP(l, W_GU), D, D, D, 0}; pg8::StaticOrder S; S.init(MP, NGU, F.G, F.bid);
            pg8::EpiD E{SLOTP(2)};
            pg8::gemm_phase(F.lds, g, S, E);
        }
        GRID_BAR();
        {
            pg8::Gemm g{SLOTP(2), WLP(l, W_DN), FF, FF, FF, 0}; pg8::StaticOrder S; S.init(MP, D, F.G, F.bid);
            pg8::EpiPlain E{SLOTP(1), D};
            pg8::gemm_phase(F.lds, g, S, E);
        }
        GRID_BAR();
        {   float* Y = outp() + O_Y;
            norm_phase(F, SLOTP(1), inp(15) + l * D, Y, Y + (size_t)NPROMPT * D, Y, l == 0 ? inp(3) + D : nullptr, l == 0 ? SLOTP(4) : nullptr); }
        if (l == 0) GRID_BAR();
    }
}

extern "C" void kernel_launch(void* const* d_in, const int* in_sizes, int n_in, void* d_out, int out_size, void* d_ws, size_t ws_size, hipStream_t stream) {
    static int grid = 0;
    if (grid == 0) {
        if (n_in != 19 || in_sizes[0] != NPROMPT * D || (size_t)out_size != O_END || ws_size < WS_END) {
            fprintf(stderr, "kernel_launch: shape mismatch: n_in %d in0 %d out %d ws %zu (need %zu)\n", n_in, n_in > 0 ? in_sizes[0] : -1, out_size, ws_size, (size_t)WS_END); grid = -1; return; }
        int dev = 0, cus = 0, per_cu = 0;
        if (hipGetDevice(&dev) != hipSuccess || hipDeviceGetAttribute(&cus, hipDeviceAttributeMultiprocessorCount, dev) != hipSuccess) { grid = -1; return; }
        if (hipFuncSetAttribute((const void*)fwd_kernel, hipFuncAttributeMaxDynamicSharedMemorySize, LDS_BYTES) != hipSuccess) { fprintf(stderr, "kernel_launch: hipFuncSetAttribute failed\n"); grid = -1; return; }
        if (hipOccupancyMaxActiveBlocksPerMultiprocessor(&per_cu, (const void*)fwd_kernel, NWAVES * 64, LDS_BYTES) != hipSuccess || per_cu < 1)
            fprintf(stderr, "kernel_launch: occupancy query reports %d workgroups per CU\n", per_cu);
        (void)hipGetLastError();
        grid = cus;
        if (grid % 8 != 0) fprintf(stderr, "kernel_launch: grid %d not a multiple of 8\n", grid);
    }
    if (grid < 0) return;
    (void)hipMemsetAsync((char*)d_ws + WS_CTL, 0, CTL_ZERO_BYTES, stream);
    Args a{};
    for (int i = 0; i < 19; ++i) a.in[i] = (const float*)d_in[i];
    a.out = (float*)d_out; a.ws = (unsigned char*)d_ws;
    hipLaunchKernelGGL(fwd_kernel, dim3(grid), dim3(NWAVES * 64), LDS_BYTES, stream, a);
}
```

```cpp
#include <hip/hip_runtime.h>
#include <cstdio>
#include <cstdint>

#define LAS __attribute__((address_space(3)))
#define GAS __attribute__((address_space(1)))
typedef unsigned short bf16_t;
typedef short bf16x8 __attribute__((ext_vector_type(8)));
typedef float f32x4 __attribute__((ext_vector_type(4)));
typedef float f32x2 __attribute__((ext_vector_type(2)));
typedef unsigned u32x4 __attribute__((ext_vector_type(4)));
typedef unsigned u32x2 __attribute__((ext_vector_type(2)));

constexpr int D = 1024, NPROMPT = 16384, NSAMP = 128, SEQ = 2048, NB = 8;
constexpr int M = NPROMPT + NSAMP;
constexpr int MP = 16640;
constexpr int INC = 7168, FF = 2816, NGU = 2 * FF;
constexpr int NA1 = 5120, NA2 = 2048;
constexpr float EPS = 1e-6f;
constexpr int NWAVES = 8;

constexpr size_t O_Y = 0, O_CP = (size_t)M * D, O_CS = O_CP + 2 * NB * 2 * D, O_V = O_CS + 2 * NSAMP * 2 * D, O_END = O_V + 2 * NSAMP * D;

constexpr size_t MiB = 1u << 20;
constexpr size_t WS_CTL = 0, CTL_ZERO_BYTES = 1 * MiB;
constexpr size_t WS_STATS = 1 * MiB;
constexpr size_t WS_SSTATS = 3 * MiB + MiB / 2;
constexpr size_t WS_W = 4 * MiB;
constexpr size_t W_IN = 0, W_AB = 14 * MiB, W_O = 18 * MiB, W_GU = 20 * MiB, W_DN = 31 * MiB, W_LAYER = 36 * MiB + MiB / 2;
constexpr size_t SLOT = (size_t)MP * D * 2;
constexpr size_t WS_S0 = WS_W + 2 * W_LAYER, WS_END = WS_S0 + 5 * SLOT;
constexpr int CW_BAR = 4096;

__device__ __forceinline__ unsigned cvt_pk_bf16(float lo, float hi) { unsigned r; asm volatile("v_cvt_pk_bf16_f32 %0, %1, %2" : "=v"(r) : "v"(lo), "v"(hi)); return r; }
__device__ __forceinline__ float bf_lo(unsigned w) { return __uint_as_float(w << 16); }
__device__ __forceinline__ float bf_hi(unsigned w) { return __uint_as_float(w & 0xffff0000u); }
__device__ __forceinline__ float fast_exp(float x) { return __builtin_amdgcn_exp2f(x * 1.44269504089f); }
__device__ __forceinline__ float sigmoidf_(float x) { return __builtin_amdgcn_rcpf(1.0f + fast_exp(-x)); }
__device__ __forceinline__ float gelu_tanh(float x) { const float u = x * (1.5957691216f + 0.0713548163f * x * x); return x * __builtin_amdgcn_rcpf(1.0f + fast_exp(-u)); }
__device__ __forceinline__ float wave_sum(float v) {
#pragma unroll
    for (int o = 1; o < 64; o <<= 1) v += __shfl_xor(v, o);
    return v;
}
#define LDS_WAIT() asm volatile("s_waitcnt lgkmcnt(0)" ::: "memory")
#define VM_WAIT() asm volatile("s_waitcnt vmcnt(0)" ::: "memory")

namespace pg8 {
constexpr int BM = 256, BK = 64, HALF = 128, HTB = HALF * BK * 2, STAGE_BYTES = 8 * HTB, NXCD = 8, WGM = 8;
__host__ __device__ __forceinline__ int lds_byte(int r, int c) { const int st = (r >> 4) * 2 + (c >> 5), rr = r & 15, cc = c & 31, ob = rr * 64 + cc * 2; return st * 1024 + (ob ^ (((ob >> 9) & 1) << 5)); }
__host__ __device__ __forceinline__ void stage_rc(int b, int& R, int& C) { const int st = b / 1024, sb = b % 1024, swz = sb ^ (((sb >> 9) & 1) << 5); R = (st >> 1) * 16 + swz / 64; C = (st & 1) * 32 + (swz % 64) / 2; }
__host__ __device__ __forceinline__ int perm32(int rho) { const int n = rho >> 4, i = rho & 15; return 8 * (i >> 2) + 4 * n + (i & 3); }

struct Unit { int pm, pn, part; };
struct Gemm { const bf16_t* A; const bf16_t* Bt; int lda, ldb, K, part_off; };

constexpr int GRID = 256;
template <int NM, int NN> struct StaticOrder {
    int c;
    __device__ __forceinline__ void init(int c_) { c = c_; }
    __device__ __forceinline__ bool next(int i, Unit& u) const {
        constexpr int nwg = NM * NN, q = nwg / NXCD, r = nwg % NXCD, nig = WGM * NN;
        const int L = i * GRID + c; if (L >= nwg) return false;
        int wgid = L; { const int xcd = wgid % NXCD, off = wgid / NXCD; wgid = (xcd < r ? xcd * (q + 1) : r * (q + 1) + (xcd - r) * q) + off; }
        const int gid = wgid / nig, fm = gid * WGM, gsz = (NM - fm) < WGM ? (NM - fm) : WGM;
        u.pm = fm + ((wgid % nig) % gsz); u.pn = (wgid % nig) / gsz; u.part = 0; return true;
    }
};
template <int NM, int NN> struct PairOrder {
    StaticOrder<NM, NN> S;
    __device__ __forceinline__ bool next(int i, Unit& u) const { if (!S.next(i >> 1, u)) return false; u.part = i & 1; return true; }
};

typedef f32x4 Acc[2][2][4][2];

template <class Epi, class Sched>
__device__ __forceinline__ void gemm_phase(LAS unsigned char* lds, const Gemm g, const Sched& S, const Epi& E) {
    int tid_ = threadIdx.x; asm volatile("" : "+v"(tid_));
    const int tid = tid_, wid = __builtin_amdgcn_readfirstlane(tid >> 6), lane = tid & 63, wr = wid >> 2, wc = wid & 3, fr = lane & 15, fq = lane >> 4;
    const int K = g.K, nt = K / BK;
    unsigned voffA[2], voffB[2];
#pragma unroll
    for (int i = 0; i < 2; ++i) { int R, C; stage_rc(tid * 16 + i * 8192, R, C); const int Rb = (R & ~31) + perm32(R & 31);
        voffA[i] = (unsigned)(R * g.lda + C) * 2u; voffB[i] = (unsigned)(Rb * g.ldb + C) * 2u; }
    const size_t kstep = (size_t)(BK * 2);
    const size_t hstepA = (size_t)HALF * g.lda * 2, hstepB = (size_t)HALF * g.ldb * 2;
    const size_t tstepA = 2 * hstepA, tstepB = 2 * hstepB, pstep = (size_t)g.part_off * 2;
    const unsigned ldsw = (unsigned)wid * 1024u;
    const int aoff = lds_byte(wr * 64 + fr, fq * 8), boff = lds_byte(wc * 32 + fr, fq * 8);
#define PG8_SA(b, h) (((b) * 2 + (h)) * HTB)
#define PG8_SB(b, h) ((4 + (b) * 2 + (h)) * HTB)
#define PG8_STAGE(bufoff, gbase, voff) do { _Pragma("unroll") for (int _i = 0; _i < 2; ++_i) \
        __builtin_amdgcn_global_load_lds((const unsigned*)((const char*)(gbase) + (voff)[_i]), (LAS unsigned*)(lds + (bufoff) + ldsw + _i * 8192), 16, 0, 0); } while (0)
#define PG8_LDA(dst, b, h) do { _Pragma("unroll") for (int m = 0; m < 4; ++m) _Pragma("unroll") for (int k = 0; k < 2; ++k) dst[m][k] = *(const LAS bf16x8*)(lds + PG8_SA(b, h) + aoff + m * 2048 + k * 1024); } while (0)
#define PG8_LDB(dst, b, h) do { _Pragma("unroll") for (int n = 0; n < 2; ++n) _Pragma("unroll") for (int k = 0; k < 2; ++k) dst[n][k] = *(const LAS bf16x8*)(lds + PG8_SB(b, h) + boff + n * 2048 + k * 1024); } while (0)
#define PG8_MMA(ai, bj, At, Bt) do { __builtin_amdgcn_s_setprio(1); _Pragma("unroll") for (int m = 0; m < 4; ++m) _Pragma("unroll") for (int n = 0; n < 2; ++n) _Pragma("unroll") for (int k = 0; k < 2; ++k) \
        acc[ai][bj][m][n] = __builtin_amdgcn_mfma_f32_16x16x32_bf16(Bt[n][k], At[m][k], acc[ai][bj][m][n], 0, 0, 0); __builtin_amdgcn_s_setprio(0); } while (0)
#define PG8_WAIT_V(n) asm volatile("s_waitcnt vmcnt(" #n ")" ::: "memory")
#define PG8_WAIT_L(n) asm volatile("s_waitcnt lgkmcnt(" #n ")" ::: "memory")
#define PG8_BAR __builtin_amdgcn_s_barrier()
#define PG8_SCHED __builtin_amdgcn_sched_barrier(0)
    Unit cur, nxt; int ui = 0;
    if (!S.next(0, cur)) return;
    Acc acc;
#pragma unroll
    for (int a = 0; a < 2; ++a)
#pragma unroll
        for (int b = 0; b < 2; ++b)
#pragma unroll
            for (int m = 0; m < 4; ++m)
#pragma unroll
                for (int n = 0; n < 2; ++n) acc[a][b][m][n] = (f32x4){0.f, 0.f, 0.f, 0.f};
    bf16x8 At[4][2], B0[2][2], B1[2][2];
    const char* cA = (const char*)g.A + (size_t)cur.pm * tstepA + (size_t)cur.part * pstep; const char* cB = (const char*)g.Bt + (size_t)cur.pn * tstepB + (size_t)cur.part * pstep;
    PG8_STAGE(PG8_SB(0, 0), cB, voffB); PG8_STAGE(PG8_SB(0, 1), cB + hstepB, voffB); PG8_STAGE(PG8_SA(0, 0), cA, voffA); PG8_STAGE(PG8_SA(0, 1), cA + hstepA, voffA);
    if (wr == 1) PG8_BAR;
    PG8_WAIT_V(2); PG8_BAR;
    PG8_STAGE(PG8_SB(1, 0), cB + kstep, voffB); PG8_STAGE(PG8_SA(1, 0), cA + kstep, voffA); PG8_STAGE(PG8_SB(1, 1), cB + hstepB + kstep, voffB);
    PG8_WAIT_V(6); PG8_BAR;
    for (;;) {
        const bool has_next = S.next(ui + 1, nxt);
        const char* nA = has_next ? (const char*)g.A + (size_t)nxt.pm * tstepA + (size_t)nxt.part * pstep : cA;
        const char* nB = has_next ? (const char*)g.Bt + (size_t)nxt.pn * tstepB + (size_t)nxt.part * pstep : cB;
        for (int t = 0; t < nt; t += 2) {
            const bool last = (t == nt - 2);
            const char* a1 = cA + (size_t)(t + 1) * kstep;
            const char* a2 = last ? nA : cA + (size_t)(t + 2) * kstep; const char* b2 = last ? nB : cB + (size_t)(t + 2) * kstep;
            const char* a3 = a2 + kstep; const char* b3 = b2 + kstep;
            PG8_LDB(B0, 0, 0); PG8_LDB(B1, 0, 1); PG8_SCHED; PG8_LDA(At, 0, 0); PG8_STAGE(PG8_SA(1, 1), a1 + hstepA, voffA);
            PG8_WAIT_V(8); PG8_WAIT_L(0); PG8_BAR; PG8_MMA(0, 0, At, B0); PG8_MMA(0, 1, At, B1); PG8_BAR; PG8_SCHED;
            PG8_LDA(At, 0, 1); PG8_STAGE(PG8_SB(0, 0), b2, voffB); PG8_STAGE(PG8_SB(0, 1), b2 + hstepB, voffB); PG8_STAGE(PG8_SA(0, 0), a2, voffA);
            PG8_WAIT_V(8); PG8_WAIT_L(0); PG8_BAR; PG8_MMA(1, 0, At, B0); PG8_MMA(1, 1, At, B1); PG8_BAR; PG8_SCHED;
            PG8_LDB(B0, 1, 0); PG8_LDB(B1, 1, 1); PG8_SCHED; PG8_LDA(At, 1, 0); PG8_STAGE(PG8_SA(0, 1), a2 + hstepA, voffA);
            PG8_WAIT_V(8); PG8_WAIT_L(0); PG8_BAR; PG8_MMA(0, 0, At, B0); PG8_MMA(0, 1, At, B1); PG8_BAR; PG8_SCHED;
            PG8_LDA(At, 1, 1); PG8_STAGE(PG8_SB(1, 0), b3, voffB); PG8_STAGE(PG8_SB(1, 1), b3 + hstepB, voffB); PG8_STAGE(PG8_SA(1, 0), a3, voffA);
            PG8_WAIT_V(8); PG8_WAIT_L(0); PG8_BAR; PG8_MMA(1, 0, At, B0); PG8_MMA(1, 1, At, B1); PG8_BAR; PG8_SCHED;
        }
        if (wr == 0) PG8_BAR;
        E(acc, cur, wr, wc, fr, fq);
        if (!has_next) break;
        if (nxt.part == 0) {
#pragma unroll
            for (int a = 0; a < 2; ++a)
#pragma unroll
                for (int b = 0; b < 2; ++b)
#pragma unroll
                    for (int m = 0; m < 4; ++m)
#pragma unroll
                        for (int n = 0; n < 2; ++n) acc[a][b][m][n] = (f32x4){0.f, 0.f, 0.f, 0.f};
        }
        cur = nxt; cA = nA; cB = nB; ++ui;
        if (wr == 1) PG8_BAR;
    }
    PG8_WAIT_V(0);
    PG8_BAR;
#undef PG8_SA
#undef PG8_SB
#undef PG8_STAGE
#undef PG8_LDA
#undef PG8_LDB
#undef PG8_MMA
#undef PG8_WAIT_V
#undef PG8_WAIT_L
#undef PG8_BAR
#undef PG8_SCHED
}

__device__ __forceinline__ u32x4 pack8(const f32x4 v0, const f32x4 v1) { u32x4 w; w.x = cvt_pk_bf16(v0[0], v0[1]); w.y = cvt_pk_bf16(v0[2], v0[3]); w.z = cvt_pk_bf16(v1[0], v1[1]); w.w = cvt_pk_bf16(v1[2], v1[3]); return w; }

struct EpiPlain {
    bf16_t* O; int ldc;
    __device__ __forceinline__ void operator()(Acc& acc, const Unit& u, int wr, int wc, int fr, int fq) const {
        const int row0 = u.pm * BM + wr * 64 + fr, col0 = u.pn * BM + wc * 32 + 8 * fq;
#pragma unroll
        for (int ai = 0; ai < 2; ++ai)
#pragma unroll
            for (int m = 0; m < 4; ++m) { bf16_t* rowp = O + (size_t)(row0 + ai * HALF + m * 16) * ldc + col0;
#pragma unroll
                for (int bj = 0; bj < 2; ++bj) *(u32x4*)(rowp + bj * HALF) = pack8(acc[ai][bj][m][0], acc[ai][bj][m][1]); }
    }
};

struct EpiA1 {
    bf16_t* UB; bf16_t* GV; bf16_t* CIN; float* STATS; float* out_cp;
    __device__ __forceinline__ void operator()(Acc& acc, const Unit& u, int wr, int wc, int fr, int fq) const {
        const int row0 = u.pm * BM + wr * 64 + fr, t = u.pn, cl = wc * 32 + 8 * fq;
        if (t < 4 || (t >= 8 && t < 12)) {
            const bool isu = t < 4; const int col0 = (isu ? t * 256 : 1024 + (t - 8) * 256) + cl;
#pragma unroll
            for (int ai = 0; ai < 2; ++ai)
#pragma unroll
                for (int m = 0; m < 4; ++m) { bf16_t* rowp = UB + (size_t)(row0 + ai * HALF + m * 16) * 2048 + col0;
#pragma unroll
                    for (int bj = 0; bj < 2; ++bj) { f32x4 v0 = acc[ai][bj][m][0], v1 = acc[ai][bj][m][1];
                        if (isu) {
#pragma unroll
                            for (int e = 0; e < 4; ++e) { v0[e] = gelu_tanh(v0[e]); v1[e] = gelu_tanh(v1[e]); } }
                        *(u32x4*)(rowp + bj * HALF) = pack8(v0, v1); } }
        } else if (t < 8) {
            const int col0 = (t - 4) * 256 + cl;
#pragma unroll
            for (int ai = 0; ai < 2; ++ai)
#pragma unroll
                for (int m = 0; m < 4; ++m) { const int row = row0 + ai * HALF + m * 16; bf16_t* rowp = GV + (size_t)row * D + col0; float s = 0.f, q = 0.f;
#pragma unroll
                    for (int bj = 0; bj < 2; ++bj) { f32x4 v0 = acc[ai][bj][m][0], v1 = acc[ai][bj][m][1];
#pragma unroll
                        for (int e = 0; e < 4; ++e) { v0[e] = gelu_tanh(v0[e]); v1[e] = gelu_tanh(v1[e]); s += v0[e] + v1[e]; q += v0[e] * v0[e] + v1[e] * v1[e]; }
                        *(u32x4*)(rowp + bj * HALF) = pack8(v0, v1); }
                    s += __shfl_xor(s, 16); s += __shfl_xor(s, 32); q += __shfl_xor(q, 16); q += __shfl_xor(q, 32);
                    if (fq == 0) *(f32x2*)(STATS + (size_t)row * 32 + ((t - 4) * 4 + wc) * 2) = (f32x2){s, q}; }
        } else {
            const int col0 = (t - 12) * 128 + cl;
#pragma unroll
            for (int ai = 0; ai < 2; ++ai)
#pragma unroll
                for (int m = 0; m < 4; ++m) { const int row = row0 + ai * HALF + m * 16;
                    const f32x4 p0 = acc[ai][0][m][0] * acc[ai][1][m][0], p1 = acc[ai][0][m][1] * acc[ai][1][m][1];
                    *(u32x4*)(CIN + (size_t)row * D + col0) = pack8(p0, p1);
                    const int tp = row & (SEQ - 1);
                    if (tp >= SEQ - 2) { float* o = out_cp + ((size_t)(row >> 11) * 2 + (tp - (SEQ - 2))) * D + col0; *(f32x4*)o = p0; *(f32x4*)(o + 4) = p1; } }
        }
    }
};
struct EpiA2 {
    bf16_t* RATIO; bf16_t* SB;
    __device__ __forceinline__ void operator()(Acc& acc, const Unit& u, int wr, int wc, int fr, int fq) const {
        const int row0 = u.pm * BM + wr * 64 + fr, col0 = u.pn * 128 + wc * 32 + 8 * fq;
#pragma unroll
        for (int ai = 0; ai < 2; ++ai)
#pragma unroll
            for (int m = 0; m < 4; ++m) { const size_t off = (size_t)(row0 + ai * HALF + m * 16) * D + col0; f32x4 rt[2], sb[2];
#pragma unroll
                for (int n = 0; n < 2; ++n)
#pragma unroll
                    for (int e = 0; e < 4; ++e) { const float ea = 1.0f + fast_exp(-acc[ai][0][m][n][e]), eb = 1.0f + fast_exp(-acc[ai][1][m][n][e]); const float ra = __builtin_amdgcn_rcpf(ea);
                        sb[n][e] = __builtin_amdgcn_rcpf(eb); rt[n][e] = eb * ra; }
                *(u32x4*)(RATIO + off) = pack8(rt[0], rt[1]); *(u32x4*)(SB + off) = pack8(sb[0], sb[1]); }
    }
};
struct EpiB {
    const bf16_t* RATIO; const bf16_t* SB; bf16_t* H;
    __device__ __forceinline__ void operator()(Acc& acc, const Unit& u, int wr, int wc, int fr, int fq) const {
        const int row0 = u.pm * BM + wr * 64 + fr, col0 = u.pn * BM + wc * 32 + 8 * fq;
        const bf16_t* S = u.part == 0 ? RATIO : SB;
#pragma unroll
        for (int ai = 0; ai < 2; ++ai)
#pragma unroll
            for (int m = 0; m < 4; ++m) { const size_t off = (size_t)(row0 + ai * HALF + m * 16) * D + col0;
#pragma unroll
                for (int bj = 0; bj < 2; ++bj) { const u32x4 w = *(const u32x4*)(S + off + bj * HALF);
                    f32x4 s0 = {bf_lo(w.x), bf_hi(w.x), bf_lo(w.y), bf_hi(w.y)}, s1 = {bf_lo(w.z), bf_hi(w.z), bf_lo(w.w), bf_hi(w.w)};
                    acc[ai][bj][m][0] *= s0; acc[ai][bj][m][1] *= s1;
                    if (u.part == 1) *(u32x4*)(H + off + bj * HALF) = pack8(acc[ai][bj][m][0], acc[ai][bj][m][1]); } }
    }
};
struct EpiD {
    bf16_t* Aout;
    __device__ __forceinline__ void operator()(Acc& acc, const Unit& u, int wr, int wc, int fr, int fq) const {
        const int row0 = u.pm * BM + wr * 64 + fr, col0 = u.pn * 128 + wc * 32 + 8 * fq;
#pragma unroll
        for (int ai = 0; ai < 2; ++ai)
#pragma unroll
            for (int m = 0; m < 4; ++m) { f32x4 o[2];
#pragma unroll
                for (int n = 0; n < 2; ++n)
#pragma unroll
                    for (int e = 0; e < 4; ++e) { const float gte = acc[ai][0][m][n][e]; o[n][e] = gte * sigmoidf_(gte) * acc[ai][1][m][n][e]; }
                *(u32x4*)(Aout + (size_t)(row0 + ai * HALF + m * 16) * FF + col0) = pack8(o[0], o[1]); }
    }
};
}

#define XB_TMO      128
#define XB_XCNT(j)  (256  + 64 * (j))
#define XB_XSUB(j)  (1280 + 64 * (j))
#define XB_XGEN(j)  (2304 + 64 * (j))
#define XB_TOP      3328
#define XB_TOPGEN   3392
#define XCD_BAR_WORDS 3456
#define XB_SPIN_CAP (1u << 18)
__device__ __forceinline__ unsigned xb_ld(unsigned* p)              { return __hip_atomic_load(p, __ATOMIC_RELAXED, __HIP_MEMORY_SCOPE_AGENT); }
__device__ __forceinline__ unsigned xb_add(unsigned* p, unsigned v) { return __hip_atomic_fetch_add(p, v, __ATOMIC_RELAXED, __HIP_MEMORY_SCOPE_AGENT); }
__device__ __forceinline__ unsigned xb_xcc_id() { return (unsigned)__builtin_amdgcn_s_getreg((3 << 11) | 20) & 0xFu; }
#define XB_SPIN(cond, bar) do { unsigned _sp = 0; while (cond) { __builtin_amdgcn_s_sleep(1); \
    if ((++_sp & 255u) == 0u) { if (xb_ld(&(bar)[XB_TMO])) break; if (_sp > XB_SPIN_CAP) { atomicAdd(&(bar)[XB_TMO], 1u); break; } } } } while (0)
struct XcdBarrier { unsigned* bar; unsigned x; volatile LAS unsigned* st; };
__device__ __forceinline__ XcdBarrier xcd_barrier_post(unsigned* bar, volatile LAS unsigned* st) {
    XcdBarrier b; b.bar = bar; b.x = xb_xcc_id(); b.st = st;
    if (threadIdx.x == 0) (void)xb_add(&bar[XB_XCNT(b.x)], 1u);
    return b;
}
__device__ __forceinline__ void xcd_barrier_complete(unsigned* bar, unsigned x, unsigned& nloc, unsigned& nx) {
    const unsigned G = gridDim.x * gridDim.y * gridDim.z;
    unsigned sum, cnt, mine, sp = 0u;
    for (;;) {
        sum = 0u; cnt = 0u; mine = 0u;
#pragma unroll
        for (unsigned j = 0; j < 16; ++j) { const unsigned c = xb_ld(&bar[XB_XCNT(j)]); sum += c; cnt += (c > 0u) ? 1u : 0u; mine = (j == x) ? c : mine; }
        if (sum == G) break;
        __builtin_amdgcn_s_sleep(1);
        if ((++sp & 255u) == 0u) { if (xb_ld(&bar[XB_TMO])) break; if (sp > XB_SPIN_CAP) { atomicAdd(&bar[XB_TMO], 1u); break; } }
    }
    nloc = mine > 0u ? mine : 1u; nx = cnt > 0u ? cnt : 1u;
}
__device__ __forceinline__ void xcd_barrier(const XcdBarrier& b) {
    asm volatile("s_waitcnt vmcnt(0)" ::: "memory");
    __syncthreads();
    if (threadIdx.x == 0) {
        unsigned* bar = b.bar;
        __builtin_amdgcn_s_waitcnt(0);
        unsigned nloc = b.st[0], nx = b.st[1];
        if (nloc == 0u) { xcd_barrier_complete(bar, b.x, nloc, nx); b.st[0] = nloc; b.st[1] = nx; }
        const unsigned old = xb_add(&bar[XB_XSUB(b.x)], 1u);
        const unsigned gen = old / nloc;
        if (old + 1u == (gen + 1u) * nloc) {
            __builtin_amdgcn_fence(__ATOMIC_RELEASE, "agent");
            asm volatile("s_waitcnt vmcnt(0)" ::: "memory");
            const unsigned og = xb_add(&bar[XB_TOP], 1u);
            const unsigned tg = og / nx;
            if (og + 1u == (tg + 1u) * nx) xb_add(&bar[XB_TOPGEN], 1u);
            else XB_SPIN(xb_ld(&bar[XB_TOPGEN]) == tg, bar);
            __builtin_amdgcn_fence(__ATOMIC_ACQUIRE, "agent");
            xb_add(&bar[XB_XGEN(b.x)], 1u);
            asm volatile("s_waitcnt vmcnt(0)" ::: "memory");
        } else {
            XB_SPIN(xb_ld(&bar[XB_XGEN(b.x)]) == gen, bar);
            __builtin_amdgcn_fence(__ATOMIC_ACQUIRE, "agent");
            asm volatile("s_waitcnt vmcnt(0)" ::: "memory");
        }
    }
    __syncthreads();
}

constexpr int RING_BYTES = 131072, LDSCTL_OFF = RING_BYTES, MISC_OFF = LDSCTL_OFF + 320, LDS_BYTES = 147456;
struct Args { const float* in[19]; float* out; unsigned char* ws; };
struct Frame { LAS unsigned char* lds; int tid, lane, wave, bid; };
#define CAS __attribute__((address_space(4)))
typedef const CAS unsigned char* kptr_t;
__device__ __forceinline__ kptr_t kargs() { kptr_t p = (kptr_t)__builtin_amdgcn_kernarg_segment_ptr(); asm volatile("" : "+s"(p)); return p; }
__device__ __forceinline__ const float* inp(int i) { return *(const float* const CAS*)(kargs() + 8 * i); }
__device__ __forceinline__ float* outp() { return *(float* const CAS*)(kargs() + 8 * 19); }
__device__ __forceinline__ unsigned char* wsp() { return *(unsigned char* const CAS*)(kargs() + 8 * 20); }

__device__ __forceinline__ void transpose_item(const float* W, int N, int k0, int scol0, bf16_t* WT, int drow0, int ldk, int koff, LAS float* scr, int lane) {
#pragma unroll 8
    for (int i = 0; i < 32; ++i) { const int kk = 2 * i + (lane >> 5); scr[kk * 33 + (lane & 31)] = W[(size_t)(k0 + kk) * N + scol0 + (lane & 31)]; }
    LDS_WAIT(); asm volatile("" ::: "memory");
    const int c = lane & 7;
#pragma unroll
    for (int j = 0; j < 4; ++j) { const int n = (lane >> 3) + 8 * j; const LAS float* s = scr + (8 * c) * 33 + n;
        u32x4 o; o.x = cvt_pk_bf16(s[0 * 33], s[1 * 33]); o.y = cvt_pk_bf16(s[2 * 33], s[3 * 33]); o.z = cvt_pk_bf16(s[4 * 33], s[5 * 33]); o.w = cvt_pk_bf16(s[6 * 33], s[7 * 33]);
        *(u32x4*)(WT + (size_t)(drow0 + n) * ldk + koff + k0 + 8 * c) = o; }
    LDS_WAIT(); asm volatile("" ::: "memory");
}
__device__ __forceinline__ int win_src(int p) {
    const int t = p >> 8, r = p & 255;
    if (t < 12) return p;
    if (t < 20) { const int j = t - 12; return r < 128 ? 3072 + 128 * j + r : 4096 + 128 * j + (r - 128); }
    const int j = t - 20; return r < 128 ? 5120 + 128 * j + r : 6144 + 128 * j + (r - 128);
}
__device__ __forceinline__ void p0_weights(Frame& F) {
    LAS float* scr = (LAS float*)(F.lds + F.wave * 16384);
    const int gw = F.bid * NWAVES + F.wave, NGW = pg8::GRID * NWAVES;
    constexpr int I_IN = 16 * (INC / 32), I_SQ = 16 * (D / 32), I_GU = 16 * (NGU / 32), I_DN = (FF / 64) * (D / 32);
    constexpr int PER_LAYER = I_IN + 3 * I_SQ + I_GU + I_DN;
    for (int it = gw; it < 2 * PER_LAYER; it += NGW) {
        const int l = it / PER_LAYER; int r = it % PER_LAYER;
        unsigned char* wl = wsp() + WS_W + (size_t)l * W_LAYER;
        if (r < I_IN) { const int nb = r % (INC / 32), kb = r / (INC / 32); transpose_item(inp(5) + (size_t)l * D * INC, INC, 64 * kb, win_src(32 * nb), (bf16_t*)(wl + W_IN), 32 * nb, D, 0, scr, F.lane); continue; } r -= I_IN;
        if (r < I_SQ) { const int nb = r % 32, kb = r / 32; transpose_item(inp(11) + (size_t)l * D * D, D, 64 * kb, 32 * nb, (bf16_t*)(wl + W_AB), 32 * nb, 2048, 0, scr, F.lane); continue; } r -= I_SQ;
        if (r < I_SQ) { const int nb = r % 32, kb = r / 32; transpose_item(inp(12) + (size_t)l * D * D, D, 64 * kb, 32 * nb, (bf16_t*)(wl + W_AB), 32 * nb, 2048, 1024, scr, F.lane); continue; } r -= I_SQ;
        if (r < I_SQ) { const int nb = r % 32, kb = r / 32; transpose_item(inp(13) + (size_t)l * D * D, D, 64 * kb, 32 * nb, (bf16_t*)(wl + W_O), 32 * nb, D, 0, scr, F.lane); continue; } r -= I_SQ;
        if (r < I_GU) { const int nb = r % (NGU / 32), kb = r / (NGU / 32); const int p = 32 * nb, j = p >> 8, rr = p & 255;
            const float* W = (rr < 128 ? inp(16) : inp(17)) + (size_t)l * D * FF; const int sc = 128 * j + (rr & 127);
            transpose_item(W, FF, 64 * kb, sc, (bf16_t*)(wl + W_GU), p, D, 0, scr, F.lane); continue; } r -= I_GU;
        { const int nb = r % 32, kb = r / 32; transpose_item(inp(18) + (size_t)l * FF * D, D, 64 * kb, 32 * nb, (bf16_t*)(wl + W_DN), 32 * nb, FF, 0, scr, F.lane); }
    }
}

__device__ __forceinline__ void norm_phase(Frame& F, const bf16_t* src, const float* g_res, const float* xin_prompt, const float* xin_sample, float* xout, const float* g_next, bf16_t* xn) {
    int tid_ = threadIdx.x; asm volatile("" : "+v"(tid_));
    const int lane = tid_ & 63, wave = __builtin_amdgcn_readfirstlane(tid_ >> 6);
    const int gw = F.bid * NWAVES + wave, NGW = pg8::GRID * NWAVES;
    f32x4 gr[4], gn[4];
#pragma unroll
    for (int j = 0; j < 4; ++j) { gr[j] = g_res ? *(const f32x4*)(g_res + 4 * lane + 256 * j) : (f32x4){0.f, 0.f, 0.f, 0.f}; gn[j] = g_next ? *(const f32x4*)(g_next + 4 * lane + 256 * j) : (f32x4){0.f, 0.f, 0.f, 0.f}; }
    for (int row = gw; row < M; row += NGW) {
        const float* xr = row < NPROMPT ? xin_prompt + (size_t)row * D : xin_sample + (size_t)(row - NPROMPT) * D;
        f32x4 x[4];
#pragma unroll
        for (int j = 0; j < 4; ++j) x[j] = *(const f32x4*)(xr + 4 * lane + 256 * j);
        if (src) {
            f32x4 o[4]; float ss = 0.f;
#pragma unroll
            for (int j = 0; j < 4; ++j) { const u32x2 w = *(const u32x2*)(src + (size_t)row * D + 4 * lane + 256 * j); o[j] = (f32x4){bf_lo(w.x), bf_hi(w.x), bf_lo(w.y), bf_hi(w.y)};
                ss += (o[j][0] * o[j][0] + o[j][1] * o[j][1]) + (o[j][2] * o[j][2] + o[j][3] * o[j][3]); }
            const float rs = 1.0f / sqrtf(wave_sum(ss) * (1.0f / D) + EPS);
#pragma unroll
            for (int j = 0; j < 4; ++j) x[j] = x[j] + o[j] * rs * gr[j];
        }
        if (xout) {
#pragma unroll
            for (int j = 0; j < 4; ++j) *(f32x4*)(xout + (size_t)row * D + 4 * lane + 256 * j) = x[j]; }
        if (xn) {
            float ss = 0.f;
#pragma unroll
            for (int j = 0; j < 4; ++j) ss += (x[j][0] * x[j][0] + x[j][1] * x[j][1]) + (x[j][2] * x[j][2] + x[j][3] * x[j][3]);
            const float rs = 1.0f / sqrtf(wave_sum(ss) * (1.0f / D) + EPS);
#pragma unroll
            for (int j = 0; j < 4; ++j) { const f32x4 y = x[j] * rs * gn[j]; *(u32x2*)(xn + (size_t)row * D + 4 * lane + 256 * j) = (u32x2){cvt_pk_bf16(y[0], y[1]), cvt_pk_bf16(y[2], y[3])}; }
        }
    }
}

constexpr int MP_PITCH = 136;
constexpr int MX_WS = 0, MX_VT = 128 * MP_PITCH * 2, MX_ST = 2 * 128 * MP_PITCH * 2;
__device__ __forceinline__ void mix_phase(Frame& F, int l) {
    int tid_ = threadIdx.x; asm volatile("" : "+v"(tid_));
    const int tid = tid_, lane = tid & 63, wave = __builtin_amdgcn_readfirstlane(tid >> 6), h = F.bid & 7;
    bf16_t* UB = (bf16_t*)(wsp() + WS_S0); const bf16_t* GV = (const bf16_t*)(wsp() + WS_S0 + 2 * SLOT); const bf16_t* CIN = (const bf16_t*)(wsp() + WS_S0 + 3 * SLOT);
    const float* STATS = (const float*)(wsp() + WS_STATS);
    LAS bf16_t* WSl = (LAS bf16_t*)(F.lds + MX_WS); LAS bf16_t* VT = (LAS bf16_t*)(F.lds + MX_VT); LAS f32x2* ST = (LAS f32x2*)(F.lds + MX_ST);
    const float* Ws = inp(8) + ((size_t)l * 8 + h) * 128 * 128;
    for (int idx = tid; idx < 128 * 32; idx += NWAVES * 64) { const int i = idx >> 5, j4 = (idx & 31) * 4; const f32x4 w = *(const f32x4*)(Ws + i * 128 + j4);
        const float a = j4 + 0 <= i ? w[0] : 0.f, b = j4 + 1 <= i ? w[1] : 0.f, c = j4 + 2 <= i ? w[2] : 0.f, d = j4 + 3 <= i ? w[3] : 0.f;
        *(LAS u32x2*)(WSl + i * MP_PITCH + j4) = (u32x2){cvt_pk_bf16(a, b), cvt_pk_bf16(c, d)}; }
    const int d8 = tid & 15, cb = 128 * h + 8 * d8;
    float lg[8], lb[8], cw0[8], cw1[8], cw2[8];
#pragma unroll
    for (int e = 0; e < 8; ++e) { lg[e] = inp(6)[l * D + cb + e]; lb[e] = inp(7)[l * D + cb + e]; cw0[e] = inp(10)[(l * 3 + 0) * D + cb + e]; cw1[e] = inp(10)[(l * 3 + 1) * D + cb + e]; cw2[e] = inp(10)[(l * 3 + 2) * D + cb + e]; }
    const float ws00 = Ws[0], bs0 = inp(9)[((size_t)l * 8 + h) * 128];
    const int nchunk = NPROMPT / 128;
    for (int c = F.bid >> 3; c <= nchunk; c += pg8::GRID >> 3) {
        const bool samp = c == nchunk; if (samp && (F.bid >> 3) != 0) break;
        const int r0 = c * 128;
#pragma unroll
        for (int q = 0; q < 4; ++q) { const int j = (tid >> 4) + 32 * q, row = r0 + j;
            u32x4 o = {0u, 0u, 0u, 0u};
            if (row < M) {
                const u32x4 c2 = *(const u32x4*)(CIN + (size_t)row * D + cb); const u32x4 bg = *(const u32x4*)(UB + (size_t)row * 2048 + 1024 + cb);
                float x1[8], x0[8];
                if (!samp) { const int tp = row & (SEQ - 1); u32x4 c1 = {0u, 0u, 0u, 0u}, c0 = {0u, 0u, 0u, 0u};
                    if (tp >= 1) c1 = *(const u32x4*)(CIN + (size_t)(row - 1) * D + cb);
                    if (tp >= 2) c0 = *(const u32x4*)(CIN + (size_t)(row - 2) * D + cb);
                    x1[0] = bf_lo(c1.x); x1[1] = bf_hi(c1.x); x1[2] = bf_lo(c1.y); x1[3] = bf_hi(c1.y); x1[4] = bf_lo(c1.z); x1[5] = bf_hi(c1.z); x1[6] = bf_lo(c1.w); x1[7] = bf_hi(c1.w);
                    x0[0] = bf_lo(c0.x); x0[1] = bf_hi(c0.x); x0[2] = bf_lo(c0.y); x0[3] = bf_hi(c0.y); x0[4] = bf_lo(c0.z); x0[5] = bf_hi(c0.z); x0[6] = bf_lo(c0.w); x0[7] = bf_hi(c0.w);
                } else { const float* hs = inp(2) + (((size_t)l * NSAMP + (row - NPROMPT)) * 2) * D + cb; float* oc = outp() + O_CS + (((size_t)l * NSAMP + (row - NPROMPT)) * 2) * D + cb;
#pragma unroll
                    for (int e = 0; e < 8; ++e) { x0[e] = hs[e]; x1[e] = hs[D + e]; oc[e] = x1[e]; } }
                const float x2[8] = {bf_lo(c2.x), bf_hi(c2.x), bf_lo(c2.y), bf_hi(c2.y), bf_lo(c2.z), bf_hi(c2.z), bf_lo(c2.w), bf_hi(c2.w)};
                const float bgf[8] = {bf_lo(bg.x), bf_hi(bg.x), bf_lo(bg.y), bf_hi(bg.y), bf_lo(bg.z), bf_hi(bg.z), bf_lo(bg.w), bf_hi(bg.w)};
                float r[8];
#pragma unroll
                for (int e = 0; e < 8; ++e) r[e] = bgf[e] * (cw0[e] * x0[e] + cw1[e] * x1[e] + cw2[e] * x2[e]);
                o.x = cvt_pk_bf16(r[0], r[1]); o.y = cvt_pk_bf16(r[2], r[3]); o.z = cvt_pk_bf16(r[4], r[5]); o.w = cvt_pk_bf16(r[6], r[7]);
            }
            *(u32x4*)(UB + (size_t)row * 2048 + 1024 + cb) = o; }
        if (tid < 128) { const float* sp = samp ? (const float*)(wsp() + WS_SSTATS) + (size_t)tid * 64 : STATS + (size_t)(r0 + tid) * 32; float s = 0.f, q = 0.f;
            const int np = samp ? 16 : 8;
            for (int k = 0; k < np; ++k) { const f32x4 p = *(const f32x4*)(sp + 4 * k); s += p[0] + p[2]; q += p[1] + p[3]; }
            const float mean = s * (1.0f / D), var = q * (1.0f / D) - mean * mean; ST[tid] = (f32x2){mean, 1.0f / sqrtf(var + EPS)}; }
        LDS_WAIT(); __syncthreads();
        if (!samp) {
#pragma unroll
            for (int q = 0; q < 4; ++q) { const int j = (tid >> 4) + 32 * q; const u32x4 g = *(const u32x4*)(GV + (size_t)(r0 + j) * D + cb); const f32x2 st = ST[j];
                const float xv[8] = {bf_lo(g.x), bf_hi(g.x), bf_lo(g.y), bf_hi(g.y), bf_lo(g.z), bf_hi(g.z), bf_lo(g.w), bf_hi(g.w)};
#pragma unroll
                for (int e = 0; e < 8; e += 2) { const float y0 = (xv[e] - st.x) * st.y * lg[e] + lb[e], y1 = (xv[e + 1] - st.x) * st.y * lg[e + 1] + lb[e + 1]; const unsigned w = cvt_pk_bf16(y0, y1);
                    VT[(8 * d8 + e) * MP_PITCH + j] = (bf16_t)(w & 0xffffu); VT[(8 * d8 + e + 1) * MP_PITCH + j] = (bf16_t)(w >> 16); } }
            LDS_WAIT(); __syncthreads();
            const int i0 = 16 * wave, fr = lane & 15, fq = lane >> 4; f32x4 acc[8];
#pragma unroll
            for (int db = 0; db < 8; ++db) acc[db] = (f32x4){0.f, 0.f, 0.f, 0.f};
            for (int k0 = 0; k0 <= i0 + 15; k0 += 32) { const bf16x8 wf = *(const LAS bf16x8*)(WSl + (i0 + fr) * MP_PITCH + k0 + 8 * fq);
#pragma unroll
                for (int db = 0; db < 8; ++db) { const bf16x8 vf = *(const LAS bf16x8*)(VT + (16 * db + fr) * MP_PITCH + k0 + 8 * fq); acc[db] = __builtin_amdgcn_mfma_f32_16x16x32_bf16(vf, wf, acc[db], 0, 0, 0); } }
            const float bsv = inp(9)[((size_t)l * 8 + h) * 128 + i0 + fr];
#pragma unroll
            for (int db = 0; db < 8; ++db) { bf16_t* up = UB + (size_t)(r0 + i0 + fr) * 2048 + 128 * h + 16 * db + 4 * fq; const u32x2 uw = *(const u32x2*)up;
                const float a0 = bf_lo(uw.x) * (acc[db][0] + bsv), a1 = bf_hi(uw.x) * (acc[db][1] + bsv), a2 = bf_lo(uw.y) * (acc[db][2] + bsv), a3 = bf_hi(uw.y) * (acc[db][3] + bsv);
                *(u32x2*)up = (u32x2){cvt_pk_bf16(a0, a1), cvt_pk_bf16(a2, a3)}; }
        } else {
#pragma unroll
            for (int q = 0; q < 4; ++q) { const int j = (tid >> 4) + 32 * q, row = r0 + j; u32x4 o = {0u, 0u, 0u, 0u};
                if (row < M) { const u32x4 g = *(const u32x4*)(GV + (size_t)row * D + cb); const u32x4 uw = *(const u32x4*)(UB + (size_t)row * 2048 + cb); const f32x2 st = ST[j];
                    const float xv[8] = {bf_lo(g.x), bf_hi(g.x), bf_lo(g.y), bf_hi(g.y), bf_lo(g.z), bf_hi(g.z), bf_lo(g.w), bf_hi(g.w)};
                    const float uf[8] = {bf_lo(uw.x), bf_hi(uw.x), bf_lo(uw.y), bf_hi(uw.y), bf_lo(uw.z), bf_hi(uw.z), bf_lo(uw.w), bf_hi(uw.w)};
                    float* ov = outp() + O_V + ((size_t)l * NSAMP + (row - NPROMPT)) * D + cb; float r[8];
#pragma unroll
                    for (int e = 0; e < 8; ++e) { const float y = (xv[e] - st.x) * st.y * lg[e] + lb[e]; ov[e] = y; r[e] = uf[e] * (ws00 * y + bs0); }
                    o.x = cvt_pk_bf16(r[0], r[1]); o.y = cvt_pk_bf16(r[2], r[3]); o.z = cvt_pk_bf16(r[4], r[5]); o.w = cvt_pk_bf16(r[6], r[7]); }
                *(u32x4*)(UB + (size_t)row * 2048 + cb) = o; }
        }
        __syncthreads();
    }
}

#define SLOTP(i) ((bf16_t*)(wsp() + WS_S0 + (size_t)(i) * SLOT))
#define WLP(l, off) ((const bf16_t*)(wsp() + WS_W + (size_t)(l) * W_LAYER + (off)))

constexpr int SP_PITCH = 36;
__device__ __forceinline__ void sgemm_strip(LAS unsigned char* lds, const bf16_t* A, int lda, const bf16_t* W, int ldb, int p0, int p1, int K, f32x4& v0, f32x4& v1) {
    int tid_ = threadIdx.x; asm volatile("" : "+v"(tid_));
    const int tid = tid_, wave = __builtin_amdgcn_readfirstlane(tid >> 6), lane = tid & 63, fr = lane & 15, fq = lane >> 4;
    const int kper = K >> 3, nsteps = kper >> 5;
    const bf16_t* ap = A + (size_t)fr * lda + wave * kper + 8 * fq;
    const bf16_t* bp0 = W + (size_t)(p0 + fr) * ldb + wave * kper + 8 * fq;
    const bf16_t* bp1 = W + (size_t)(p1 + fr) * ldb + wave * kper + 8 * fq;
    f32x4 acc[8][2];
#pragma unroll
    for (int m = 0; m < 8; ++m) { acc[m][0] = (f32x4){0.f, 0.f, 0.f, 0.f}; acc[m][1] = (f32x4){0.f, 0.f, 0.f, 0.f}; }
    bf16x8 ac[8], bc[2], an[8], bn[2];
#pragma unroll
    for (int m = 0; m < 8; ++m) ac[m] = *(const bf16x8*)(ap + (size_t)(16 * m) * lda);
    bc[0] = *(const bf16x8*)bp0; bc[1] = *(const bf16x8*)bp1;
    for (int s = 0; s < nsteps; ++s) {
        if (s + 1 < nsteps) {
#pragma unroll
            for (int m = 0; m < 8; ++m) an[m] = *(const bf16x8*)(ap + (size_t)(16 * m) * lda + 32 * (s + 1));
            bn[0] = *(const bf16x8*)(bp0 + 32 * (s + 1)); bn[1] = *(const bf16x8*)(bp1 + 32 * (s + 1));
        }
#pragma unroll
        for (int m = 0; m < 8; ++m) { acc[m][0] = __builtin_amdgcn_mfma_f32_16x16x32_bf16(bc[0], ac[m], acc[m][0], 0, 0, 0); acc[m][1] = __builtin_amdgcn_mfma_f32_16x16x32_bf16(bc[1], ac[m], acc[m][1], 0, 0, 0); }
#pragma unroll
        for (int m = 0; m < 8; ++m) ac[m] = an[m];
        bc[0] = bn[0]; bc[1] = bn[1];
    }
    LAS float* P = (LAS float*)lds;
    if (wave >= 4) { LAS float* Pw = P + (wave - 4) * 128 * SP_PITCH;
#pragma unroll
        for (int m = 0; m < 8; ++m)
#pragma unroll
            for (int n = 0; n < 2; ++n) *(LAS f32x4*)(Pw + (16 * m + fr) * SP_PITCH + 16 * n + 4 * fq) = acc[m][n]; }
    LDS_WAIT(); __syncthreads();
    if (wave < 4) { LAS float* Pw = P + wave * 128 * SP_PITCH;
#pragma unroll
        for (int m = 0; m < 8; ++m)
#pragma unroll
            for (int n = 0; n < 2; ++n) { LAS f32x4* p = (LAS f32x4*)(Pw + (16 * m + fr) * SP_PITCH + 16 * n + 4 * fq); const f32x4 t = *p + acc[m][n]; *p = t; } }
    LDS_WAIT(); __syncthreads();
    const int row = tid >> 2, q = tid & 3;
    v0 = (f32x4){0.f, 0.f, 0.f, 0.f}; v1 = v0;
#pragma unroll
    for (int w = 0; w < 4; ++w) { v0 += *(const LAS f32x4*)(P + w * 128 * SP_PITCH + row * SP_PITCH + 4 * q); v1 += *(const LAS f32x4*)(P + w * 128 * SP_PITCH + row * SP_PITCH + 16 + 4 * q); }
    LDS_WAIT(); __syncthreads();
}
__device__ __forceinline__ u32x2 pack4(const f32x4 v) { return (u32x2){cvt_pk_bf16(v[0], v[1]), cvt_pk_bf16(v[2], v[3])}; }
__device__ __forceinline__ f32x4 unpack4(const u32x2 w) { return (f32x4){bf_lo(w.x), bf_hi(w.x), bf_lo(w.y), bf_hi(w.y)}; }

template <int PH> __device__ __forceinline__ void sample_phase(Frame& F, int l) {
    const int tid = threadIdx.x, row = tid >> 2, q = tid & 3; const size_t grow = (size_t)NPROMPT + row;
    constexpr int NSTRIP = PH == 0 ? 160 : PH == 1 ? 64 : PH == 4 ? 176 : 32;
    int first = F.bid, stride = pg8::GRID;
    if (PH == 4) { if (F.bid < 128) return; first = F.bid - 128; stride = pg8::GRID - 128; }
    for (int idx = first; idx < NSTRIP; idx += stride) {
        f32x4 v0, v1;
        if (PH == 0) {
            int p0, p1; if (idx < 96) { p0 = 32 * idx; p1 = p0 + 16; } else { const int i = idx - 96; p0 = 256 * (12 + (i >> 3)) + 16 * (i & 7); p1 = p0 + 128; }
            sgemm_strip(F.lds, SLOTP(4) + (size_t)NPROMPT * D, D, WLP(l, W_IN), D, p0, p1, D, v0, v1);
            const int t = p0 >> 8;
            if (t < 4) {
#pragma unroll
                for (int e = 0; e < 4; ++e) { v0[e] = gelu_tanh(v0[e]); v1[e] = gelu_tanh(v1[e]); }
                bf16_t* o = SLOTP(0) + grow * 2048 + 4 * q; *(u32x2*)(o + p0) = pack4(v0); *(u32x2*)(o + p1) = pack4(v1);
            } else if (t < 8) {
                float s = 0.f, qq = 0.f;
#pragma unroll
                for (int e = 0; e < 4; ++e) { v0[e] = gelu_tanh(v0[e]); v1[e] = gelu_tanh(v1[e]); s += v0[e] + v1[e]; qq += v0[e] * v0[e] + v1[e] * v1[e]; }
                bf16_t* o = SLOTP(2) + grow * D + 4 * q - 1024; *(u32x2*)(o + p0) = pack4(v0); *(u32x2*)(o + p1) = pack4(v1);
                s += __shfl_xor(s, 1); s += __shfl_xor(s, 2); qq += __shfl_xor(qq, 1); qq += __shfl_xor(qq, 2);
                if (q == 0) *(f32x2*)((float*)(wsp() + WS_SSTATS) + row * 64 + ((p0 - 1024) >> 5) * 2) = (f32x2){s, qq};
            } else if (t < 12) {
                bf16_t* o = SLOTP(0) + grow * 2048 + 1024 + 4 * q - 2048; *(u32x2*)(o + p0) = pack4(v0); *(u32x2*)(o + p1) = pack4(v1);
            } else {
                const int col = 128 * (t - 12) + (p0 & 127) + 4 * q; const f32x4 c = v0 * v1;
                *(u32x2*)(SLOTP(3) + grow * D + col) = pack4(c);
                *(f32x4*)(outp() + O_CS + (((size_t)l * NSAMP + row) * 2 + 1) * D + col) = c;
            }
        } else if (PH == 1) {
            const int t = 20 + (idx >> 3), p0 = 256 * t + 16 * (idx & 7), p1 = p0 + 128;
            sgemm_strip(F.lds, SLOTP(4) + (size_t)NPROMPT * D, D, WLP(l, W_IN), D, p0, p1, D, v0, v1);
            const int col = 128 * (t - 20) + (p0 & 127) + 4 * q; f32x4 rt, sb;
#pragma unroll
            for (int e = 0; e < 4; ++e) { const float ea = 1.0f + fast_exp(-v0[e]), eb = 1.0f + fast_exp(-v1[e]); sb[e] = __builtin_amdgcn_rcpf(eb); rt[e] = eb * __builtin_amdgcn_rcpf(ea); }
            *(u32x2*)(SLOTP(2) + grow * D + col) = pack4(rt); *(u32x2*)(SLOTP(3) + grow * D + col) = pack4(sb);
        } else if (PH == 2) {
            const int p0 = 32 * idx, p1 = p0 + 16; f32x4 y0, y1;
            sgemm_strip(F.lds, SLOTP(0) + (size_t)NPROMPT * 2048, 2048, WLP(l, W_AB), 2048, p0, p1, D, y0, y1);
            sgemm_strip(F.lds, SLOTP(0) + (size_t)NPROMPT * 2048 + D, 2048, WLP(l, W_AB) + D, 2048, p0, p1, D, v0, v1);
            const bf16_t* rp = SLOTP(2) + grow * D + 4 * q; const bf16_t* sp = SLOTP(3) + grow * D + 4 * q; bf16_t* hp = SLOTP(4) + grow * D + 4 * q;
            const f32x4 h0 = unpack4(*(const u32x2*)(sp + p0)) * (unpack4(*(const u32x2*)(rp + p0)) * y0 + v0), h1 = unpack4(*(const u32x2*)(sp + p1)) * (unpack4(*(const u32x2*)(rp + p1)) * y1 + v1);
            *(u32x2*)(hp + p0) = pack4(h0); *(u32x2*)(hp + p1) = pack4(h1);
        } else if (PH == 3) {
            const int p0 = 32 * idx, p1 = p0 + 16;
            sgemm_strip(F.lds, SLOTP(4) + (size_t)NPROMPT * D, D, WLP(l, W_O), D, p0, p1, D, v0, v1);
            bf16_t* o = SLOTP(2) + grow * D + 4 * q; *(u32x2*)(o + p0) = pack4(v0); *(u32x2*)(o + p1) = pack4(v1);
        } else if (PH == 4) {
            const int t = idx >> 3, p0 = 256 * t + 16 * (idx & 7), p1 = p0 + 128;
            sgemm_strip(F.lds, SLOTP(0) + (size_t)NPROMPT * D, D, WLP(l, W_GU), D, p0, p1, D, v0, v1);
            f32x4 a;
#pragma unroll
            for (int e = 0; e < 4; ++e) a[e] = v0[e] * sigmoidf_(v0[e]) * v1[e];
            *(u32x2*)(SLOTP(2) + grow * FF + 128 * t + (p0 & 127) + 4 * q) = pack4(a);
        } else {
            const int p0 = 32 * idx, p1 = p0 + 16;
            sgemm_strip(F.lds, SLOTP(2) + (size_t)NPROMPT * FF, FF, WLP(l, W_DN), FF, p0, p1, FF, v0, v1);
            bf16_t* o = SLOTP(1) + grow * D + 4 * q; *(u32x2*)(o + p0) = pack4(v0); *(u32x2*)(o + p1) = pack4(v1);
        }
    }
}

__global__ void __launch_bounds__(NWAVES * 64, 2) fwd_kernel(Args args) {
    extern __shared__ __attribute__((aligned(16))) unsigned char lds_raw[];
    Frame F;
    F.lds = (LAS unsigned char*)lds_raw;
    F.tid = threadIdx.x; F.lane = F.tid & 63; F.wave = __builtin_amdgcn_readfirstlane(F.tid >> 6);
    F.bid = blockIdx.x;
    volatile LAS unsigned* MISC = (volatile LAS unsigned*)(F.lds + MISC_OFF);
    for (int u = F.tid; u < (LDS_BYTES - LDSCTL_OFF) / 4; u += NWAVES * 64) ((LAS unsigned*)(F.lds + LDSCTL_OFF))[u] = 0u;
    __syncthreads();
    XcdBarrier bar = xcd_barrier_post((unsigned*)(wsp() + WS_CTL) + CW_BAR, MISC + 8);
#define GRID_BAR() xcd_barrier(bar)

    p0_weights(F);
    norm_phase(F, nullptr, nullptr, inp(0), inp(1), nullptr, inp(3), SLOTP(4));
    GRID_BAR();

    for (int l = 0; l < 2; ++l) {
        sample_phase<0>(F, l);
        {
            pg8::Gemm g{SLOTP(4), WLP(l, W_IN), D, D, D, 0}; pg8::StaticOrder<64, NA1 / 256> S; S.init(F.bid);
            pg8::EpiA1 E{SLOTP(0), SLOTP(2), SLOTP(3), (float*)(wsp() + WS_STATS), outp() + O_CP + (size_t)l * NB * 2 * D};
            pg8::gemm_phase(F.lds, g, S, E);
        }
        GRID_BAR();
        mix_phase(F, l);
        GRID_BAR();
        sample_phase<1>(F, l);
        {
            pg8::Gemm g{SLOTP(4), WLP(l, W_IN) + (size_t)NA1 * D, D, D, D, 0}; pg8::StaticOrder<64, NA2 / 256> S; S.init(F.bid);
            pg8::EpiA2 E{SLOTP(2), SLOTP(3)};
            pg8::gemm_phase(F.lds, g, S, E);
        }
        GRID_BAR();
        sample_phase<2>(F, l);
        {
            pg8::Gemm g{SLOTP(0), WLP(l, W_AB), 2048, 2048, D, D}; pg8::PairOrder<64, 4> S; S.S.init(F.bid);
            pg8::EpiB E{SLOTP(2), SLOTP(3), SLOTP(4)};
            pg8::gemm_phase(F.lds, g, S, E);
        }
        GRID_BAR();
        sample_phase<3>(F, l);
        {
            pg8::Gemm g{SLOTP(4), WLP(l, W_O), D, D, D, 0}; pg8::StaticOrder<64, 4> S; S.init(F.bid);
            pg8::EpiPlain E{SLOTP(2), D};
            pg8::gemm_phase(F.lds, g, S, E);
        }
        GRID_BAR();
        {   float* Y = outp() + O_Y;
            norm_phase(F, SLOTP(2), inp(4) + l * D, l == 0 ? inp(0) : Y, l == 0 ? inp(1) : Y + (size_t)NPROMPT * D, Y, inp(14) + l * D, SLOTP(0)); }
        GRID_BAR();
        sample_phase<4>(F, l);
        {
            pg8::Gemm g{SLOTP(0), WLP(l, W_GU), D, D, D, 0}; pg8::StaticOrder<64, NGU / 256> S; S.init(F.bid);
            pg8::EpiD E{SLOTP(2)};
            pg8::gemm_phase(F.lds, g, S, E);
        }
        GRID_BAR();
        sample_phase<5>(F, l);
        {
            pg8::Gemm g{SLOTP(2), WLP(l, W_DN), FF, FF, FF, 0}; pg8::StaticOrder<64, 4> S; S.init(F.bid);
            pg8::EpiPlain E{SLOTP(1), D};
            pg8::gemm_phase(F.lds, g, S, E);
        }
        GRID_BAR();
        {   float* Y = outp() + O_Y;
            norm_phase(F, SLOTP(1), inp(15) + l * D, Y, Y + (size_t)NPROMPT * D, Y, l == 0 ? inp(3) + D : nullptr, l == 0 ? SLOTP(4) : nullptr); }
        if (l == 0) GRID_BAR();
    }
}

extern "C" void kernel_launch(void* const* d_in, const int* in_sizes, int n_in, void* d_out, int out_size, void* d_ws, size_t ws_size, hipStream_t stream) {
    static int grid = 0;
    if (grid == 0) {
        if (n_in != 19 || in_sizes[0] != NPROMPT * D || (size_t)out_size != O_END || ws_size < WS_END) {
            fprintf(stderr, "kernel_launch: shape mismatch: n_in %d in0 %d out %d ws %zu (need %zu)\n", n_in, n_in > 0 ? in_sizes[0] : -1, out_size, ws_size, (size_t)WS_END); grid = -1; return; }
        int dev = 0, cus = 0, per_cu = 0;
        if (hipGetDevice(&dev) != hipSuccess || hipDeviceGetAttribute(&cus, hipDeviceAttributeMultiprocessorCount, dev) != hipSuccess) { grid = -1; return; }
        if (hipFuncSetAttribute((const void*)fwd_kernel, hipFuncAttributeMaxDynamicSharedMemorySize, LDS_BYTES) != hipSuccess) { fprintf(stderr, "kernel_launch: hipFuncSetAttribute failed\n"); grid = -1; return; }
        if (hipOccupancyMaxActiveBlocksPerMultiprocessor(&per_cu, (const void*)fwd_kernel, NWAVES * 64, LDS_BYTES) != hipSuccess || per_cu < 1)
            fprintf(stderr, "kernel_launch: occupancy query reports %d workgroups per CU\n", per_cu);
        (void)hipGetLastError();
        if (cus < pg8::GRID) { fprintf(stderr, "kernel_launch: %d CUs, need %d\n", cus, pg8::GRID); grid = -1; return; }
        grid = pg8::GRID;
    }
    if (grid < 0) return;
    (void)hipMemsetAsync((char*)d_ws + WS_CTL, 0, CTL_ZERO_BYTES, stream);
    Args a{};
    for (int i = 0; i < 19; ++i) a.in[i] = (const float*)d_in[i];
    a.out = (float*)d_out; a.ws = (unsigned char*)d_ws;
    hipLaunchKernelGGL(fwd_kernel, dim3(grid), dim3(NWAVES * 64), LDS_BYTES, stream, a);
}
```
